# Optimizing an MI355X kernel written in HIP

```python
import jax
import jax.numpy as jnp
from jax import lax

D_MODEL = 1024
BATCH = 8
SEQ = 2048
DEPTH = 4
DEC_BATCH = 128
DEC_SEQ = 1
PAST_LEN = 2048
PAGE_SIZE = 128

N_POOL_LAYERS = DEPTH // 2
N_ATTN_LAYERS = DEPTH - N_POOL_LAYERS
POOL_WINDOWS = (2, 4, 8, 16)
POOL_GROUP_W = D_MODEL // len(POOL_WINDOWS)
POOL_HIST = max(POOL_WINDOWS) - 1
D_FF = 2816
CONV_W = 3
ATTN_GROUPS = ((128, 1), (512, 4), (2048, 16))
N_GROUPS = len(ATTN_GROUPS)
HEADS_PER_GROUP = 8
HEAD_DIM = 64
ROT_DIM = HEAD_DIM // 4
ROPE_THETA = 500000.0
ATTN_BLOCK = 128
NORM_EPS = 1e-6
NEG_INF = -1e30

kernel_name = "yoco_pool_dilated_decoder_step"


def rms_norm(x, g):
    xf = x.astype(jnp.float32)
    y = xf * lax.rsqrt(jnp.mean(xf * xf, axis=-1, keepdims=True) + NORM_EPS)
    return (y * g.astype(jnp.float32)).astype(x.dtype)


def rotary(x, pos):
    inv_freq = ROPE_THETA ** (-jnp.arange(0, ROT_DIM, 2, dtype=jnp.float32) / ROT_DIM)
    ang = pos.astype(jnp.float32)[:, None] * inv_freq[None, :]
    shape = (1, pos.shape[0]) + (1,) * (x.ndim - 3) + (ROT_DIM // 2,)
    cos = jnp.cos(ang).reshape(shape)
    sin = jnp.sin(ang).reshape(shape)
    xf = x.astype(jnp.float32)
    x1 = xf[..., : ROT_DIM // 2]
    x2 = xf[..., ROT_DIM // 2: ROT_DIM]
    out = jnp.concatenate([x1 * cos - x2 * sin, x2 * cos + x1 * sin, xf[..., ROT_DIM:]], axis=-1)
    return out.astype(x.dtype)


def pool_mixer(ext, n_hist, pos, w_pool, scale):
    B, L, D = ext.shape
    T = L - n_hist
    ef = ext.astype(jnp.float32)
    csum = jnp.concatenate([jnp.zeros((B, 1, D), jnp.float32), jnp.cumsum(ef, axis=1)], axis=1)
    hi = csum[:, n_hist + 1:]
    cur = ef[:, n_hist:]
    t_end = jnp.arange(T) + n_hist + 1
    parts = []
    for g, w in enumerate(POOL_WINDOWS):
        sl = slice(g * POOL_GROUP_W, (g + 1) * POOL_GROUP_W)
        lo = jnp.take(csum[..., sl], jnp.maximum(t_end - w, 0), axis=1)
        cnt = jnp.minimum(pos + 1, w).astype(jnp.float32)[None, :, None]
        parts.append((hi[..., sl] - lo) / cnt - cur[..., sl])
    d = jnp.stack(parts, axis=2)
    mixed = jnp.einsum('btgc,gce->btge', d, w_pool.astype(jnp.float32)).reshape(B, T, D)
    return (mixed * scale.astype(jnp.float32)).astype(ext.dtype)


def conv_ffn(x, hist, g, w_up, cw, cb, w_down):
    h = rms_norm(x, g)
    u = jnp.einsum('btd,df->btf', h, w_up)
    ext = jnp.concatenate([hist.astype(u.dtype), u], axis=1)
    T = u.shape[1]
    c = cb + sum(cw[j] * ext[:, j: j + T] for j in range(CONV_W))
    a, b = jnp.split(c, 2, axis=-1)
    out = jnp.einsum('btf,fd->btd', jax.nn.silu(a) * b, w_down)
    return out, ext[:, -(CONV_W - 1):]


def shared_kv(x, pos, g_kv, w_kv, k_gain):
    B, T, _ = x.shape
    kv = jnp.einsum('btd,de->bte', rms_norm(x, g_kv), w_kv)
    kv = kv.reshape(B, T, 2, N_GROUPS, HEADS_PER_GROUP, HEAD_DIM)
    k = rotary(rms_norm(kv[:, :, 0], k_gain), pos)
    return k, kv[:, :, 1]


def project_q(x, pos, g, w_q, q_gain):
    B, T, _ = x.shape
    q = jnp.einsum('btd,de->bte', rms_norm(x, g), w_q)
    q = q.reshape(B, T, N_GROUPS, HEADS_PER_GROUP, HEAD_DIM)
    return rotary(rms_norm(q, q_gain), pos) * (HEAD_DIM ** -0.5)


def dilated_prompt(q, k, v, dil, n_back):
    B, S, H, E = q.shape
    L = S // dil
    nb = -(-L // ATTN_BLOCK)
    Lp = nb * ATTN_BLOCK

    def blocks(a):
        a = a.reshape(B, L, dil, H, E)
        a = jnp.pad(a, ((0, 0), (0, Lp - L), (0, 0), (0, 0), (0, 0)))
        return a.reshape(B, nb, ATTN_BLOCK, dil, H, E)

    def with_prev(a):
        prev = jnp.concatenate([jnp.zeros_like(a[:, :1]), a[:, :-1]], axis=1)
        return jnp.concatenate([prev, a], axis=2)

    qb = blocks(q)
    kk = with_prev(blocks(k))
    vv = with_prev(blocks(v))
    s = jnp.einsum('bnqrhe,bnkrhe->bnrhqk', qb, kk).astype(jnp.float32)
    qi = jnp.arange(ATTN_BLOCK)[:, None] + ATTN_BLOCK
    ki = jnp.arange(2 * ATTN_BLOCK)[None, :]
    dist = qi - ki
    key_idx = jnp.arange(nb)[:, None, None] * ATTN_BLOCK - ATTN_BLOCK + ki[None]
    mask = ((dist >= 0) & (dist <= n_back))[None] & (key_idx >= 0)
    s = jnp.where(mask[None, :, None, None], s, NEG_INF)
    lse = jax.nn.logsumexp(s, axis=-1)
    p = jnp.exp(s - lse[..., None])
    o = jnp.einsum('bnrhqk,bnkrhe->bnqrhe', p, vv.astype(jnp.float32))
    o = o.reshape(B, Lp, dil, H, E)[:, :L].reshape(B, S, H, E)
    lse = jnp.transpose(lse, (0, 1, 4, 2, 3)).reshape(B, Lp, dil, H)[:, :L].reshape(B, S, H)
    return o, lse


def dilated_sample(q, k_buf, v_buf, k_new, v_new, dil, n_back):
    n_buf = k_buf.shape[1]
    T = q.shape[1]
    kext = jnp.concatenate([k_buf.astype(k_new.dtype), k_new], axis=1)
    vext = jnp.concatenate([v_buf.astype(v_new.dtype), v_new], axis=1)
    idx = n_buf + jnp.arange(T)[:, None] - dil * jnp.arange(n_back + 1)[None, :]
    valid = idx >= 0
    idx = jnp.maximum(idx, 0)
    kg = jnp.take(kext, idx, axis=1)
    vg = jnp.take(vext, idx, axis=1)
    s = jnp.einsum('bthe,btkhe->bthk', q, kg).astype(jnp.float32)
    s = jnp.where(valid[None, :, None, :], s, NEG_INF)
    lse = jax.nn.logsumexp(s, axis=-1)
    p = jnp.exp(s - lse[..., None])
    o = jnp.einsum('bthk,btkhe->bthe', p, vg.astype(jnp.float32))
    return o, lse


def dilated_mixer(q, k, v, kv_hist, w_o):
    B, T = q.shape[:2]
    outs, lses = [], []
    for g, (win, dil) in enumerate(ATTN_GROUPS):
        n_back = win // dil
        if kv_hist is None:
            o, lse = dilated_prompt(q[:, :, g], k[:, :, g], v[:, :, g], dil, n_back)
        else:
            buf = kv_hist[g]
            o, lse = dilated_sample(q[:, :, g], buf[:, :, 0], buf[:, :, 1], k[:, :, g], v[:, :, g], dil, n_back)
        outs.append(o)
        lses.append(lse)
    wts = jax.nn.softmax(jnp.stack(lses, axis=0), axis=0)
    o = jnp.sum(wts[..., None] * jnp.stack(outs, axis=0), axis=0)
    return jnp.einsum('bte,ed->btd', o.reshape(B, T, HEADS_PER_GROUP * HEAD_DIM).astype(q.dtype), w_o)


def trunk(x, pos, pool_hist, conv_hist, kv_hist, g_pool, w_pool, pool_scale, g_ffn, w_up, conv_w,
          conv_b, w_down, g_kv, w_kv, k_gain, g_attn, w_q, q_gain, w_o):
    B, T, _ = x.shape
    new_pool, new_conv = [], []
    k_sh = v_sh = None
    for layer in range(DEPTH):
        if layer < N_POOL_LAYERS:
            xn = rms_norm(x, g_pool[layer])
            if pool_hist is None:
                ext, n_hist = xn, 0
            else:
                ext = jnp.concatenate([pool_hist[layer].astype(xn.dtype), xn], axis=1)
                n_hist = pool_hist.shape[2]
            x = x + pool_mixer(ext, n_hist, pos, w_pool[layer], pool_scale[layer])
            new_pool.append(ext[:, -POOL_HIST:])
        else:
            if layer == N_POOL_LAYERS:
                k_sh, v_sh = shared_kv(x, pos, g_kv, w_kv, k_gain)
            j = layer - N_POOL_LAYERS
            q = project_q(x, pos, g_attn[j], w_q[j], q_gain[j])
            x = x + dilated_mixer(q, k_sh, v_sh, kv_hist, w_o[j])
        if conv_hist is None:
            hist = jnp.zeros((B, CONV_W - 1, 2 * D_FF), x.dtype)
        else:
            hist = conv_hist[layer]
        f_out, h_new = conv_ffn(x, hist, g_ffn[layer], w_up[layer], conv_w[layer], conv_b[layer], w_down[layer])
        x = x + f_out
        new_conv.append(h_new)
    kv_new = []
    for g, (win, _) in enumerate(ATTN_GROUPS):
        rows = jnp.stack([k_sh[:, :, g], v_sh[:, :, g]], axis=2)
        kv_new.append(rows[:, -min(win, T):] if kv_hist is None else rows)
    return x, jnp.stack(new_pool, axis=0), jnp.stack(new_conv, axis=0), kv_new


def setup_inputs(seed: int = 0) -> dict:
    key = jax.random.key(seed)
    ks = jax.random.split(key, 22)
    f32 = jnp.float32

    def nrm(k, shape, s):
        return jax.random.normal(k, shape, f32) * s

    qkv_w = N_GROUPS * HEADS_PER_GROUP * HEAD_DIM
    out_w = HEADS_PER_GROUP * HEAD_DIM
    kv_shape = lambda win: (DEC_BATCH, min(win, PAST_LEN), 2, HEADS_PER_GROUP, HEAD_DIM)
    return {
        'x_prompt': nrm(ks[0], (BATCH, SEQ, D_MODEL), 1.0),
        'x_sample': nrm(ks[1], (DEC_BATCH, DEC_SEQ, D_MODEL), 1.0),
        'state_pool': nrm(ks[2], (N_POOL_LAYERS, DEC_BATCH, POOL_HIST, D_MODEL), 1.0),
        'state_conv': nrm(ks[3], (DEPTH, DEC_BATCH, CONV_W - 1, 2 * D_FF), 1.0),
        'cache_kv_w128': nrm(ks[4], kv_shape(ATTN_GROUPS[0][0]), 1.0),
        'cache_kv_w512': nrm(ks[5], kv_shape(ATTN_GROUPS[1][0]), 1.0),
        'cache_kv_w2048': nrm(ks[6], kv_shape(ATTN_GROUPS[2][0]), 1.0),
        'g_pool': 1.0 + nrm(ks[7], (N_POOL_LAYERS, D_MODEL), 0.05),
        'w_pool': nrm(ks[8], (N_POOL_LAYERS, len(POOL_WINDOWS), POOL_GROUP_W, POOL_GROUP_W), POOL_GROUP_W ** -0.5),
        'pool_scale': 1.0 + nrm(ks[9], (N_POOL_LAYERS, D_MODEL), 0.05),
        'g_ffn': 1.0 + nrm(ks[10], (DEPTH, D_MODEL), 0.05),
        'w_up': nrm(ks[11], (DEPTH, D_MODEL, 2 * D_FF), D_MODEL ** -0.5),
        'conv_w': nrm(ks[12], (DEPTH, CONV_W, 2 * D_FF), CONV_W ** -0.5),
        'conv_b': nrm(ks[13], (DEPTH, 2 * D_FF), 0.01),
        'w_down': nrm(ks[14], (DEPTH, D_FF, D_MODEL), D_FF ** -0.5),
        'g_kv': 1.0 + nrm(ks[15], (D_MODEL,), 0.05),
        'w_kv': nrm(ks[16], (D_MODEL, 2 * qkv_w), D_MODEL ** -0.5),
        'k_gain': 1.0 + nrm(ks[17], (HEAD_DIM,), 0.05),
        'g_attn': 1.0 + nrm(ks[18], (N_ATTN_LAYERS, D_MODEL), 0.05),
        'w_q': nrm(ks[19], (N_ATTN_LAYERS, D_MODEL, qkv_w), D_MODEL ** -0.5),
        'q_gain': 1.0 + nrm(ks[20], (N_ATTN_LAYERS, HEAD_DIM), 0.05),
        'w_o': nrm(ks[21], (N_ATTN_LAYERS, out_w, D_MODEL), out_w ** -0.5),
    }


def reference(x_prompt, x_sample, state_pool, state_conv, cache_kv_w128, cache_kv_w512, cache_kv_w2048,
              g_pool, w_pool, pool_scale, g_ffn, w_up, conv_w, conv_b, w_down, g_kv, w_kv, k_gain,
              g_attn, w_q, q_gain, w_o):
    pos_p = jnp.arange(x_prompt.shape[1], dtype=jnp.int32)
    y_p, pool_p, conv_p, kv_p = trunk(x_prompt, pos_p, None, None, None, g_pool, w_pool, pool_scale,
                                      g_ffn, w_up, conv_w, conv_b, w_down, g_kv, w_kv, k_gain,
                                      g_attn, w_q, q_gain, w_o)
    pos_s = PAST_LEN + jnp.arange(x_sample.shape[1], dtype=jnp.int32)
    y_s, pool_s, conv_s, kv_s = trunk(x_sample, pos_s, state_pool, state_conv,
                                      (cache_kv_w128, cache_kv_w512, cache_kv_w2048),
                                      g_pool, w_pool, pool_scale, g_ffn, w_up, conv_w, conv_b, w_down,
                                      g_kv, w_kv, k_gain, g_attn, w_q, q_gain, w_o)
    return (y_p, y_s, pool_p, pool_s, conv_p, conv_s, kv_p[0], kv_s[0], kv_p[1], kv_s[1], kv_p[2], kv_s[2])
```

```cpp
#include <hip/hip_runtime.h>
#include <cstdio>
#include <cstdint>

#define LAS __attribute__((address_space(3)))
#define GAS __attribute__((address_space(1)))
typedef unsigned short bf16_t;
typedef short bf16x8 __attribute__((ext_vector_type(8)));
typedef short s16x4 __attribute__((ext_vector_type(4)));
typedef float f32x4 __attribute__((ext_vector_type(4)));
typedef float f32x2 __attribute__((ext_vector_type(2)));
typedef unsigned u32x4 __attribute__((ext_vector_type(4)));
typedef unsigned u32x2 __attribute__((ext_vector_type(2)));
typedef GAS unsigned gu32;

constexpr int DM = 1024, NBATCH = 8, SEQ = 2048, MTOK = NBATCH * SEQ, NSMP = 128, DFF = 2816, DUP = 2 * DFF;
constexpr int NHEAD = 8, HD = 64, NGRP = 3, QW = NGRP * NHEAD * HD  , OW = NHEAD * HD  , KVW = 2 * QW  ;
constexpr int PHIST = 15;
constexpr int SMP_ROW0 = 252 * 65 + 126 - 2;
constexpr float NORM_EPS = 1e-6f;
constexpr float LOG2E = 1.4426950408889634f;

enum { IN_XP = 0, IN_XS, IN_SPOOL, IN_SCONV, IN_C128, IN_C512, IN_C2048, IN_GPOOL, IN_WPOOL, IN_PSCALE, IN_GFFN, IN_WUP, IN_CONVW, IN_CONVB, IN_WDOWN,
       IN_GKV, IN_WKV, IN_KGAIN, IN_GATTN, IN_WQ, IN_QGAIN, IN_WO, N_IN };
constexpr size_t O_YP = 0, O_YS = O_YP + (size_t)MTOK * DM, O_POOLP = O_YS + (size_t)NSMP * DM, O_POOLS = O_POOLP + (size_t)2 * NBATCH * PHIST * DM,
                 O_CONVP = O_POOLS + (size_t)2 * NSMP * PHIST * DM, O_CONVS = O_CONVP + (size_t)4 * NBATCH * 2 * DUP, O_KV128P = O_CONVS + (size_t)4 * NSMP * 2 * DUP,
                 O_KV128S = O_KV128P + (size_t)NBATCH * 128 * 1024, O_KV512P = O_KV128S + (size_t)NSMP * 1024, O_KV512S = O_KV512P + (size_t)NBATCH * 512 * 1024,
                 O_KV2048P = O_KV512S + (size_t)NSMP * 1024, O_KV2048S = O_KV2048P + (size_t)NBATCH * 2048 * 1024, O_END = O_KV2048S + (size_t)NSMP * 1024;
static_assert(O_END == 49627136, "output size");

constexpr size_t MiB = 1u << 20;
constexpr size_t WS_CTL = 0, CTL_ZERO_BYTES = 512 * 1024;
constexpr size_t WS_ROT = 2 * MiB;
constexpr size_t WS_SMP = 482 * MiB;
constexpr size_t WS_WP = 8 * MiB;
constexpr size_t WS_WO = 10 * MiB;
constexpr size_t WS_WKVQ = 12 * MiB;
constexpr size_t WS_WQ3 = 22 * MiB;
constexpr size_t WS_WDOWN = 26 * MiB;
constexpr size_t WS_WUP = 50 * MiB;
constexpr size_t WS_XB = 98 * MiB;
constexpr size_t XB_PAD_ROWS = 256, XB_TAIL_ROWS = 512;
constexpr size_t WS_DBUF = 132 * MiB;
constexpr size_t WS_ACT = 164 * MiB;
constexpr size_t WS_QB = 256 * MiB, WS_KB = 304 * MiB, WS_VB = 352 * MiB;
constexpr size_t WS_OB = 400 * MiB;
constexpr size_t WS_OPART = 416 * MiB;
constexpr size_t WS_LPART = 480 * MiB;
constexpr size_t WS_END = 490 * MiB;
static_assert(WS_XB + (XB_PAD_ROWS + MTOK + XB_TAIL_ROWS) * 2048 <= WS_DBUF && WS_ACT + (size_t)MTOK * DFF * 2 <= WS_QB, "ws map");

constexpr int CW_TMO = 0, CW_CODE = 1;
constexpr int CW_BAR = 4096;
constexpr int SS_STRIDE = MTOK + 512, SS_FRONT = 64;
constexpr int CW_SSP = 8192;
constexpr int CW_SSS = CW_SSP + 7 * SS_STRIDE + 64;
constexpr int CW_SUB = CW_SSS + 8 * 128;
constexpr int CW_END = CW_SUB + 64;
static_assert((size_t)CW_END * 4 <= CTL_ZERO_BYTES, "CTL words inside the memset region");

constexpr size_t SM_XS = 0;
constexpr size_t SM_XSB = SM_XS + 128 * 1024 * 4;
constexpr size_t SM_DS = SM_XSB + 128 * 1024 * 2;
constexpr size_t SM_ACT = SM_DS + 128 * 1024 * 2;
constexpr size_t SM_Q = SM_ACT + 128 * 2816 * 2;
constexpr size_t SM_KN = SM_Q + 128 * 1536 * 4;
constexpr size_t SM_VN = SM_KN + 128 * 1536 * 4;
constexpr size_t SM_OP = SM_VN + 128 * 1536 * 4;
constexpr size_t SM_LP = SM_OP + 6 * 128 * 512 * 4;
constexpr size_t SM_OA = SM_LP + 6 * 128 * 8 * 4;
constexpr size_t SM_END = SM_OA + 128 * 512 * 2;
static_assert(SM_END <= 8 * MiB, "sample buffers");

constexpr int RING_OFF = 0, RING_BYTES = 131072;
constexpr int LDSCTL_OFF = RING_BYTES, MISC_OFF = LDSCTL_OFF + 320;
constexpr int LDS_BYTES = 163840;
constexpr int NWAVES = 8;

#define RLX_AGENT __ATOMIC_RELAXED, __HIP_MEMORY_SCOPE_AGENT
#define LDS_WAIT() asm volatile("s_waitcnt lgkmcnt(0)" ::: "memory")
#define VM_WAIT() asm volatile("s_waitcnt vmcnt(0)" ::: "memory")

__device__ __forceinline__ unsigned f2bf(float f) { unsigned u = __builtin_bit_cast(unsigned, f); return (u + 0x7fffu + ((u >> 16) & 1u)) >> 16; }
__device__ __forceinline__ unsigned pk2(float lo, float hi) { return f2bf(lo) | (f2bf(hi) << 16); }
typedef __bf16 bf16x2_t __attribute__((ext_vector_type(2)));
__device__ __forceinline__ unsigned cvt_pk_bf16(float lo, float hi) { const f32x2 v = {lo, hi}; return __builtin_bit_cast(unsigned, __builtin_convertvector(v, bf16x2_t)); }
__device__ __forceinline__ float bf2f(unsigned short b) { return __builtin_bit_cast(float, (unsigned)b << 16); }
__device__ __forceinline__ float shfl_xor_f(float v, int o) { int t; asm volatile("v_mbcnt_lo_u32_b32 %0, -1, 0\n\tv_mbcnt_hi_u32_b32 %0, -1, %0" : "=v"(t));
    return __builtin_bit_cast(float, __builtin_amdgcn_ds_bpermute((t ^ o) << 2, __builtin_bit_cast(int, v))); }
__device__ __forceinline__ float wave_sum(float v) {
#pragma unroll
    for (int o = 1; o < 64; o <<= 1) v += shfl_xor_f(v, o);
    return v;
}
__device__ __forceinline__ float dpp_shr1(float x) { return __builtin_bit_cast(float, __builtin_amdgcn_update_dpp(0, __builtin_bit_cast(int, x), 0x111, 0xf, 0xf, true)); }
__device__ __forceinline__ f32x4 dpp_shr1(f32x4 v) { return (f32x4){dpp_shr1(v[0]), dpp_shr1(v[1]), dpp_shr1(v[2]), dpp_shr1(v[3])}; }

namespace pg8 {
constexpr int BM = 256, BK = 64, HALF = 128, HTB = HALF * BK * 2  , STAGE_BYTES = 8 * HTB, NXCD = 8, WGM = 8;

__host__ __device__ __forceinline__ int lds_byte(int r, int c) { const int st = (r >> 4) * 2 + (c >> 5), rr = r & 15, cc = c & 31, ob = rr * 64 + cc * 2; return st * 1024 + (ob ^ (((ob >> 9) & 1) << 5)); }
__host__ __device__ __forceinline__ void stage_rc(int b, int& R, int& C) { const int st = b / 1024, sb = b % 1024, swz = sb ^ (((sb >> 9) & 1) << 5); R = (st >> 1) * 16 + swz / 64; C = (st & 1) * 32 + (swz % 64) / 2; }
__host__ __device__ __forceinline__ int perm32(int rho) { const int n = rho >> 4, i = rho & 15; return 8 * (i >> 2) + 4 * n + (i & 3); }

struct Unit { int pm, pn; };
struct Gemm { const bf16_t* A; const bf16_t* Bt; int K; int lda; long tstepA; long hstepA; long pnstepA; };

struct StaticOrder {
    int nM, nN, nwg, G, c, rev;
    __host__ __device__ void init(int nM_, int nN_, int G_, int c_, int rev_ = 0) { nM = nM_; nN = nN_; nwg = nM * nN; G = G_; c = c_; rev = rev_; }
    __host__ __device__ bool next(int i, Unit& u) const {
        const long L = (long)i * G + c; if (L >= nwg) return false;
        int wgid = rev ? nwg - 1 - (int)L : (int)L; { const int q = nwg / NXCD, r = nwg % NXCD, xcd = wgid % NXCD, off = wgid / NXCD; wgid = (xcd < r ? xcd * (q + 1) : r * (q + 1) + (xcd - r) * q) + off; }
        const int nig = WGM * nN, gid = wgid / nig, fm = gid * WGM, gsz = (nM - fm) < WGM ? (nM - fm) : WGM;
        u.pm = fm + ((wgid % nig) % gsz); u.pn = (wgid % nig) / gsz; return true;
    }
    __device__ __forceinline__ void a_ready(const Unit&) const {}
    __device__ __forceinline__ void done(const Unit&) const {}
};

struct UpOrder {
    int G, c, sp0;
    __host__ __device__ void init(int G_, int c_) { G = G_; c = c_; const int lo = (66 * 22) % G_; sp0 = (lo + 22 <= G_) ? lo : 65 * 22; }
    __host__ __device__ bool next(int i, Unit& u) const {
        const long L = (long)i * G + c; if (L >= 66 * 22) return false;
        if (L >= sp0 && L < sp0 + 22) { u.pm = 65; u.pn = (int)L - sp0; return true; }
        constexpr int nM = 65, nN = 22, nwg = nM * nN;
        int wgid; { const int r = (int)(L % NXCD), s1 = sp0 + 22, Lc = (int)L < sp0 ? sp0 : ((int)L < s1 ? (int)L : s1);
#define UPO_CNT(x, rr) (((x) + NXCD - 1 - (rr)) / NXCD)
            int off = UPO_CNT((int)L, r) - (UPO_CNT(Lc, r) - UPO_CNT(sp0, r)), base = 0;
            for (int q = 0; q < r; ++q) base += UPO_CNT(66 * 22, q) - (UPO_CNT(s1, q) - UPO_CNT(sp0, q));
#undef UPO_CNT
            wgid = base + off; }
        const int nig = WGM * nN, gid = wgid / nig, fm = gid * WGM, gsz = (nM - fm) < WGM ? (nM - fm) : WGM;
        u.pm = fm + ((wgid % nig) % gsz); u.pn = (wgid % nig) / gsz; return true;
    }
    __device__ __forceinline__ void a_ready(const Unit&) const {}
    __device__ __forceinline__ void done(const Unit&) const {}
};

template <int AMAP> __host__ __device__ __forceinline__ int a_rowmap(int R) { return AMAP == 0 ? R : 126 * (R >> 6) + 8 * (R & 15) + ((R >> 4) & 3); }

template <class Epi, class Sched, int AMAP, bool ALIGN_EPI = true, bool SP2 = true>
__device__ __forceinline__ void gemm_phase(LAS unsigned char* lds, const Gemm g, const Sched& S, const Epi& E, const int tid) {
    const int wid = __builtin_amdgcn_readfirstlane(tid >> 6), lane = tid & 63, wr = wid >> 2, wc = wid & 3, fr = lane & 15, fq = lane >> 4;
    const int K = g.K, nt = K / BK;
    unsigned voffA[2], voffB[2];
#pragma unroll
    for (int i = 0; i < 2; ++i) { int R, C; stage_rc(tid * 16 + i * 8192, R, C); const int Rb = Epi::PERM ? ((R & ~31) + perm32(R & 31)) : R;
        voffA[i] = (unsigned)(a_rowmap<AMAP>(R) * g.lda + C) * 2u; voffB[i] = (unsigned)(Rb * K + C) * 2u; }
    const size_t kstep = (size_t)(BK * 2);
    const size_t hA = (size_t)g.hstepA;
    const size_t hB = (size_t)HALF * K * 2;
    const size_t tB = 2 * hB;
    const unsigned ldsw = (unsigned)wid * 1024u;
    const int aoff = lds_byte(wr * 64 + fr, fq * 8), boff = lds_byte(wc * 32 + fr, fq * 8);
#define PG8_SA(b, h) (((b) * 2 + (h)) * HTB)
#define PG8_SB(b, h) ((4 + (b) * 2 + (h)) * HTB)
#define PG8_STAGE(bufoff, gbase, voff) do { _Pragma("unroll") for (int _i = 0; _i < 2; ++_i) \
        __builtin_amdgcn_global_load_lds((const unsigned*)((const char*)(gbase) + (voff)[_i]), (LAS unsigned*)(lds + (bufoff) + ldsw + _i * 8192), 16, 0, 0); } while (0)
#define PG8_LDA(dst, b, h) do { _Pragma("unroll") for (int m = 0; m < 4; ++m) _Pragma("unroll") for (int k = 0; k < 2; ++k) dst[m][k] = *(const LAS bf16x8*)(lds + PG8_SA(b, h) + aoff + m * 2048 + k * 1024); } while (0)
#define PG8_LDB(dst, b, h) do { _Pragma("unroll") for (int n = 0; n < 2; ++n) _Pragma("unroll") for (int k = 0; k < 2; ++k) dst[n][k] = *(const LAS bf16x8*)(lds + PG8_SB(b, h) + boff + n * 2048 + k * 1024); } while (0)
#define PG8_MMA(ai, bj, At, Bt) do { __builtin_amdgcn_s_setprio(1); _Pragma("unroll") for (int m = 0; m < 4; ++m) _Pragma("unroll") for (int n = 0; n < 2; ++n) _Pragma("unroll") for (int k = 0; k < 2; ++k) \
        acc[ai][bj][m][n] = __builtin_amdgcn_mfma_f32_16x16x32_bf16(Bt[n][k], At[m][k], acc[ai][bj][m][n], 0, 0, 0); __builtin_amdgcn_s_setprio(0); } while (0)
#define PG8_WAIT_V(n) asm volatile("s_waitcnt vmcnt(" #n ")" ::: "memory")
#define PG8_WAIT_L(n) asm volatile("s_waitcnt lgkmcnt(" #n ")" ::: "memory")
#define PG8_BAR __builtin_amdgcn_s_barrier()
#define PG8_SCHED __builtin_amdgcn_sched_barrier(0)
    Unit cur, nxt; int ui = 0;
    if (!S.next(0, cur)) return;
    f32x4 acc[2][2][4][2];
#pragma unroll
    for (int a = 0; a < 2; ++a)
#pragma unroll
        for (int b = 0; b < 2; ++b)
#pragma unroll
            for (int m = 0; m < 4; ++m)
#pragma unroll
                for (int n = 0; n < 2; ++n) acc[a][b][m][n] = (f32x4){0.f, 0.f, 0.f, 0.f};
    bf16x8 At[4][2], B0[2][2], B1[2][2];
    const char* cA = (const char*)g.A + (long)cur.pm * g.tstepA + (long)cur.pn * g.pnstepA; const char* cB = (const char*)g.Bt + (size_t)cur.pn * tB;
    S.a_ready(cur);
    E.prime(cur, tid);
    if constexpr (SP2) {
        PG8_STAGE(PG8_SB(0, 0), cB, voffB); PG8_STAGE(PG8_SB(0, 1), cB + hB, voffB); PG8_STAGE(PG8_SA(0, 0), cA, voffA); PG8_STAGE(PG8_SA(0, 1), cA + hA, voffA);
        if (wr == 1) PG8_BAR;
        PG8_WAIT_V(2); PG8_BAR;
        PG8_STAGE(PG8_SB(1, 0), cB + kstep, voffB); PG8_STAGE(PG8_SA(1, 0), cA + kstep, voffA); PG8_STAGE(PG8_SB(1, 1), cB + hB + kstep, voffB);
        PG8_WAIT_V(6); PG8_BAR;
    } else {
        PG8_STAGE(PG8_SB(0, 0), cB, voffB); PG8_STAGE(PG8_SA(0, 0), cA, voffA); PG8_STAGE(PG8_SB(0, 1), cB + hB, voffB); PG8_STAGE(PG8_SA(0, 1), cA + hA, voffA);
        if (wr == 1) PG8_BAR;
        PG8_WAIT_V(4); PG8_BAR;
        PG8_STAGE(PG8_SB(1, 0), cB + kstep, voffB); PG8_STAGE(PG8_SA(1, 0), cA + kstep, voffA); PG8_STAGE(PG8_SB(1, 1), cB + hB + kstep, voffB);
        PG8_WAIT_V(6); PG8_BAR;
    }
    for (;;) {
        const bool has_next = S.next(ui + 1, nxt);
        const char* nA = has_next ? (const char*)g.A + (long)nxt.pm * g.tstepA + (long)nxt.pn * g.pnstepA : cA; const char* nB = has_next ? (const char*)g.Bt + (size_t)nxt.pn * tB : cB;
        for (int t = 0; t < nt; t += 2) {
            const bool last = (t == nt - 2);
            const char* a1 = cA + (size_t)(t + 1) * kstep;
            const char* a2 = last ? nA : cA + (size_t)(t + 2) * kstep; const char* b2 = last ? nB : cB + (size_t)(t + 2) * kstep;
            const char* a3 = a2 + kstep; const char* b3 = b2 + kstep;
            if (last && has_next) S.a_ready(nxt);
            if constexpr (SP2) {
            PG8_LDB(B0, 0, 0); PG8_LDB(B1, 0, 1); PG8_SCHED; PG8_LDA(At, 0, 0); PG8_STAGE(PG8_SA(1, 1), a1 + hA, voffA);
            PG8_WAIT_V(8); PG8_WAIT_L(0); PG8_BAR; PG8_MMA(0, 0, At, B0); PG8_MMA(0, 1, At, B1); PG8_BAR; PG8_SCHED;
            PG8_LDA(At, 0, 1); PG8_STAGE(PG8_SB(0, 0), b2, voffB); PG8_STAGE(PG8_SB(0, 1), b2 + hB, voffB); PG8_STAGE(PG8_SA(0, 0), a2, voffA);
            PG8_WAIT_V(8); PG8_WAIT_L(0); PG8_BAR; PG8_MMA(1, 0, At, B0); PG8_MMA(1, 1, At, B1); PG8_BAR; PG8_SCHED;
            PG8_LDB(B0, 1, 0); PG8_LDB(B1, 1, 1); PG8_SCHED; PG8_LDA(At, 1, 0); PG8_STAGE(PG8_SA(0, 1), a2 + hA, voffA);
            PG8_WAIT_V(8); PG8_WAIT_L(0); PG8_BAR; PG8_MMA(0, 0, At, B0); PG8_MMA(0, 1, At, B1); PG8_BAR; PG8_SCHED;
            PG8_LDA(At, 1, 1); PG8_STAGE(PG8_SB(1, 0), b3, voffB); PG8_STAGE(PG8_SB(1, 1), b3 + hB, voffB); PG8_STAGE(PG8_SA(1, 0), a3, voffA);
            PG8_WAIT_V(8); PG8_WAIT_L(0); PG8_BAR; PG8_MMA(1, 0, At, B0); PG8_MMA(1, 1, At, B1); PG8_BAR; PG8_SCHED;
            } else {
            PG8_LDB(B0, 0, 0); PG8_SCHED; PG8_LDA(At, 0, 0); PG8_STAGE(PG8_SA(1, 1), a1 + hA, voffA);
            PG8_WAIT_L(8); PG8_BAR; PG8_WAIT_L(0); PG8_MMA(0, 0, At, B0); PG8_BAR; PG8_SCHED;
            PG8_LDB(B1, 0, 1); PG8_STAGE(PG8_SB(0, 0), b2, voffB);
            PG8_BAR; PG8_WAIT_L(0); PG8_MMA(0, 1, At, B1); PG8_BAR;
            PG8_LDA(At, 0, 1); PG8_STAGE(PG8_SA(0, 0), a2, voffA);
            PG8_BAR; PG8_WAIT_L(0); PG8_MMA(1, 0, At, B0); PG8_BAR; PG8_SCHED;
            PG8_STAGE(PG8_SB(0, 1), b2 + hB, voffB);
            PG8_WAIT_V(6); PG8_BAR; PG8_MMA(1, 1, At, B1); PG8_BAR;
            PG8_LDB(B0, 1, 0); PG8_SCHED; PG8_LDA(At, 1, 0); PG8_STAGE(PG8_SA(0, 1), a2 + hA, voffA);
            PG8_WAIT_L(8); PG8_BAR; PG8_WAIT_L(0); PG8_MMA(0, 0, At, B0); PG8_BAR; PG8_SCHED;
            PG8_LDB(B1, 1, 1); PG8_STAGE(PG8_SB(1, 0), b3, voffB);
            PG8_BAR; PG8_WAIT_L(0); PG8_MMA(0, 1, At, B1); PG8_BAR;
            PG8_LDA(At, 1, 1); PG8_STAGE(PG8_SA(1, 0), a3, voffA);
            PG8_BAR; PG8_WAIT_L(0); PG8_MMA(1, 0, At, B0); PG8_BAR; PG8_SCHED;
            PG8_STAGE(PG8_SB(1, 1), b3 + hB, voffB);
            PG8_WAIT_V(6); PG8_BAR; PG8_MMA(1, 1, At, B1); PG8_BAR;
            }
        }
        if constexpr (ALIGN_EPI) { if (wr == 0) PG8_BAR; }
        E(acc, cur, wr, wc, fr, fq, ui, has_next, nxt); S.done(cur);
        if (!has_next) break;
#pragma unroll
        for (int a = 0; a < 2; ++a)
#pragma unroll
            for (int b = 0; b < 2; ++b)
#pragma unroll
                for (int m = 0; m < 4; ++m)
#pragma unroll
                    for (int n = 0; n < 2; ++n) acc[a][b][m][n] = (f32x4){0.f, 0.f, 0.f, 0.f};
        cur = nxt; cA = nA; cB = nB; ++ui;
        if constexpr (ALIGN_EPI) { if (wr == 1) PG8_BAR; }
    }
    PG8_WAIT_V(0);
    if constexpr (!ALIGN_EPI) { if (wr == 0) PG8_BAR; }
    PG8_BAR;
#undef PG8_SA
#undef PG8_SB
#undef PG8_STAGE
#undef PG8_LDA
#undef PG8_LDB
#undef PG8_MMA
#undef PG8_WAIT_V
#undef PG8_WAIT_L
#undef PG8_BAR
#undef PG8_SCHED
}


struct EpiResid {
    static constexpr bool PERM = true;
    const float* xin32; float* xout32; bf16_t* xb; float* ss;
    __device__ __forceinline__ void prime(const Unit&, int) const {}
    __device__ __forceinline__ void operator()(f32x4 (&acc)[2][2][4][2], const Unit& u, int wr, int wc, int fr, int fq, int, bool, const Unit&) const {
        const int row0 = u.pm * BM + wr * 64 + fr, col0 = u.pn * BM + wc * 32 + 8 * fq;
#pragma unroll
        for (int ai = 0; ai < 2; ++ai)
#pragma unroll
            for (int m = 0; m < 4; ++m) {
                const int row = row0 + ai * HALF + m * 16; const size_t off = (size_t)row * DM + col0; float s = 0.f;
#pragma unroll
                for (int bj = 0; bj < 2; ++bj) {
                    f32x4 x0, x1;
                    if (xin32) { x0 = *(const f32x4*)(xin32 + off + bj * HALF); x1 = *(const f32x4*)(xin32 + off + bj * HALF + 4); }
                    else { const u32x4 xv = *(const u32x4*)(xb + off + bj * HALF);
                        x0 = (f32x4){__builtin_bit_cast(float, xv.x << 16), __builtin_bit_cast(float, xv.x & 0xffff0000u), __builtin_bit_cast(float, xv.y << 16), __builtin_bit_cast(float, xv.y & 0xffff0000u)};
                        x1 = (f32x4){__builtin_bit_cast(float, xv.z << 16), __builtin_bit_cast(float, xv.z & 0xffff0000u), __builtin_bit_cast(float, xv.w << 16), __builtin_bit_cast(float, xv.w & 0xffff0000u)}; }
                    const f32x4 v0 = acc[ai][bj][m][0] + x0, v1 = acc[ai][bj][m][1] + x1;
                    if (xout32) { *(f32x4*)(xout32 + off + bj * HALF) = v0; *(f32x4*)(xout32 + off + bj * HALF + 4) = v1; }
                    u32x4 w; w.x = cvt_pk_bf16(v0[0], v0[1]); w.y = cvt_pk_bf16(v0[2], v0[3]); w.z = cvt_pk_bf16(v1[0], v1[1]); w.w = cvt_pk_bf16(v1[2], v1[3]);
                    *(u32x4*)(xb + off + bj * HALF) = w;
                    s += (v0[0] * v0[0] + v0[1] * v0[1]) + (v0[2] * v0[2] + v0[3] * v0[3]) + (v1[0] * v1[0] + v1[1] * v1[1]) + (v1[2] * v1[2] + v1[3] * v1[3]);
                }
                s += shfl_xor_f(s, 16); s += shfl_xor_f(s, 32);
                if (fq == 0 && ss) unsafeAtomicAdd(ss + row, s);
                if (m == 3) asm volatile("" ::: "memory");
            }
    }
};

struct EpiUp {
    static constexpr bool PERM = true;
    bf16_t* act; const float* ss; const float* cw; const float* cb; float* convp; LAS float* pl; int layer;
    struct CP { f32x4 w0a, w1a, w2a, cba, w0b, w1b, w2b, cbb; };
    static constexpr int PLB = 8 * 32 * 4 + 256;
    __device__ __forceinline__ CP ldcp(const LAS float* p, int cq) const { CP c; const LAS f32x4* q = (const LAS f32x4*)p + cq;
        c.w0a = q[0]; c.w1a = q[32]; c.w2a = q[64]; c.cba = q[96]; c.w0b = q[128]; c.w1b = q[160]; c.w2b = q[192]; c.cbb = q[224]; return c; }
    __device__ __forceinline__ f32x4 fetch(const Unit& u, int tid) const {
        if (tid < 256) { const int arr = tid >> 5, f = 128 * u.pn + 4 * (tid & 31) + (arr >= 4 ? DFF : 0), a3 = arr & 3;
            return a3 == 3 ? *(const f32x4*)(cb + f) : *(const f32x4*)(cw + a3 * DUP + f); }
        const float sv = ss[252 * u.pm - 2 + (tid - 256)]; return (f32x4){__builtin_amdgcn_rsqf(sv * (1.f / DM) + NORM_EPS), 0.f, 0.f, 0.f};
    }
    __device__ __forceinline__ void stash(LAS float* p, int tid, const f32x4 v) const { if (tid < 256) ((LAS f32x4*)p)[tid] = v; else p[8 * 32 * 4 + (tid - 256)] = v[0]; }
    __device__ __forceinline__ void prime(const Unit& u, int tid) const { asm volatile("" : "+v"(tid)); stash(pl, tid, fetch(u, tid)); }
    template <bool SQS>
    __device__ __forceinline__ void body(f32x4 (&acc)[2][2][4][2], int t0, int f0, int fr, const LAS float* pc, int cq) const {
#pragma unroll
        for (int n = 0; n < 2; ++n) {
            const int fa = f0 + 4 * n; const CP c = ldcp(pc, cq + n);
            f32x4 ua2 = dpp_shr1(acc[1][0][2][n]), ua1 = dpp_shr1(acc[1][0][3][n]), ub2 = dpp_shr1(acc[1][1][2][n]), ub1 = dpp_shr1(acc[1][1][3][n]);
#pragma unroll
            for (int e = 0; e < 8; ++e) {
                const f32x4 ua = acc[e >> 2][0][e & 3][n], ub = acc[e >> 2][1][e & 3][n];
                f32x4 xa1 = ua1, xa2 = ua2, xb1 = ub1, xb2 = ub2;
                if (SQS) { const int pos = (t0 + e) & (SEQ - 1); const f32x4 z = (f32x4){0.f, 0.f, 0.f, 0.f};
                    if (pos < 1) { xa1 = z; xb1 = z; } if (pos < 2) { xa2 = z; xb2 = z; } }
                const f32x4 ca = c.cba + c.w2a * ua + c.w1a * xa1 + c.w0a * xa2, cv = c.cbb + c.w2b * ub + c.w1b * xb1 + c.w0b * xb2;
                float r[4];
#pragma unroll
                for (int q = 0; q < 4; ++q) { const float ex = __builtin_amdgcn_exp2f(-LOG2E * ca[q]); r[q] = ca[q] * __builtin_amdgcn_rcpf(1.f + ex) * cv[q]; }
                const int t = t0 + e;
                if (t >= 0 && t < MTOK && !(fr == 0 && e < 2)) { u32x2 w; w.x = cvt_pk_bf16(r[0], r[1]); w.y = cvt_pk_bf16(r[2], r[3]); *(u32x2*)(act + (size_t)t * DFF + fa) = w; }
                ua2 = ua1; ua1 = ua; ub2 = ub1; ub1 = ub;
            }
            __builtin_amdgcn_sched_barrier(0);
        }
    }
    __device__ __forceinline__ void body_smp(f32x4 (&acc)[2][2][4][2], int b0, int f0, const LAS float* pc, int cq) const {
        const unsigned long long hv = ((volatile LAS unsigned long long*)((LAS unsigned char*)pl - 1024 + 64))[IN_SCONV];
        const unsigned long long hp = ((unsigned long long)__builtin_amdgcn_readfirstlane((unsigned)(hv >> 32)) << 32) | (unsigned)__builtin_amdgcn_readfirstlane((unsigned)hv);
        const float* hist = (const float*)(const GAS float*)hp + (size_t)layer * NSMP * 2 * DUP;
        float* convs = convp + ((long)O_CONVS - (long)O_CONVP) + (long)layer * (NSMP - NBATCH) * 2 * DUP;
        bf16_t* acts = (bf16_t*)((unsigned char*)act + (WS_SMP + SM_ACT - WS_ACT));
#pragma unroll
        for (int n = 0; n < 2; ++n) {
            const int fa = f0 + 4 * n; const CP c = ldcp(pc, cq + n);
#pragma unroll
            for (int e = 0; e < 8; ++e) { const unsigned hb = (unsigned)((b0 + e) * 2 * DUP + fa);
                const f32x4 ua = acc[e >> 2][0][e & 3][n], ub = acc[e >> 2][1][e & 3][n];
                const f32x4 h0a = *(const f32x4*)(hist + hb), h1a = *(const f32x4*)(hist + hb + DUP), h0b = *(const f32x4*)(hist + hb + DFF), h1b = *(const f32x4*)(hist + hb + DUP + DFF);
                const f32x4 ca = c.cba + c.w2a * ua + c.w1a * h1a + c.w0a * h0a, cv = c.cbb + c.w2b * ub + c.w1b * h1b + c.w0b * h0b;
                float r[4];
#pragma unroll
                for (int q = 0; q < 4; ++q) { const float ex = __builtin_amdgcn_exp2f(-LOG2E * ca[q]); r[q] = ca[q] * __builtin_amdgcn_rcpf(1.f + ex) * cv[q]; }
                u32x2 w; w.x = cvt_pk_bf16(r[0], r[1]); w.y = cvt_pk_bf16(r[2], r[3]); *(u32x2*)(acts + (unsigned)((b0 + e) * DFF + fa)) = w;
                *(f32x4*)(convs + hb) = h1a; *(f32x4*)(convs + hb + DUP) = ua; *(f32x4*)(convs + hb + DFF) = h1b; *(f32x4*)(convs + hb + DUP + DFF) = ub;
                __builtin_amdgcn_sched_barrier(0);
            }
        }
    }
    __device__ __forceinline__ void operator()(f32x4 (&acc)[2][2][4][2], const Unit& u, int wr, int wc, int fr, int fq, int ui, bool has_next, const Unit& nxt) const {
        const int T0 = 252 * u.pm + 126 * wr - 2; int tid = (4 * wr + wc) * 64 + 16 * fq + fr;
        asm volatile("" : "+v"(tid));
        const int wr2 = tid >> 8, wc2 = (tid >> 6) & 3, fq2 = (tid >> 4) & 3, fr2 = tid & 15, t0 = T0 + 8 * fr2, f0 = 128 * u.pn + 32 * wc2 + 8 * fq2;
        const LAS float* pc = pl + (ui & 1) * PLB;
        f32x4 nv = {0.f, 0.f, 0.f, 0.f}; if (has_next) nv = fetch(nxt, tid);
        {
#pragma unroll
            for (int e = 0; e < 8; ++e) { const float rs = pc[8 * 32 * 4 + 126 * wr2 + 8 * fr2 + e];
#pragma unroll
                for (int bj = 0; bj < 2; ++bj)
#pragma unroll
                    for (int n = 0; n < 2; ++n) acc[e >> 2][bj][e & 3][n] *= rs; }
        }
        __builtin_amdgcn_sched_barrier(0);
        if (T0 >= 0 && ((T0 & (SEQ - 1)) >= SEQ - 2 - 127)) {
#pragma unroll
            for (int e = 0; e < 8; ++e) { const int t = t0 + e, pos = t & (SEQ - 1);
                if (t < MTOK && pos >= SEQ - 2 && !(fr2 == 0 && e < 2)) { float* dst = convp + ((size_t)(t >> 11) * 2 + (pos - (SEQ - 2))) * DUP + f0;
#pragma unroll
                    for (int n = 0; n < 2; ++n) { *(f32x4*)(dst + 4 * n) = acc[e >> 2][0][e & 3][n]; *(f32x4*)(dst + DFF + 4 * n) = acc[e >> 2][1][e & 3][n]; } } }
        }
        __builtin_amdgcn_sched_barrier(0);
        const int z = ((T0 + SEQ) >> 11) << 11;
        if (u.pm == 65 && wr == 1) body_smp(acc, 8 * fr2, f0, pc, 8 * wc2 + 2 * fq2);
        else if (z <= T0 + 127) body<true>(acc, t0, f0, fr2, pc, 8 * wc2 + 2 * fq2); else body<false>(acc, t0, f0, fr2, pc, 8 * wc2 + 2 * fq2);
        if (has_next) stash(pl + ((ui + 1) & 1) * PLB, tid, nv);
    }
};

struct EpiQKV {
    static constexpr bool PERM = true;
    const float* ss; const float* rot; unsigned char* wsb; float* outb; const float* kgain; long qgain_delta; float qscale; int qtile0; const LAS float* rotd;
    __device__ __forceinline__ void prime(const Unit&, int) const {}
    __device__ __forceinline__ void operator()(f32x4 (&acc)[2][2][4][2], const Unit& u, int wr, int wc, int fr, int fq, int, bool, const Unit&) const {
        const int pn = u.pn; const int type = pn >= qtile0 ? 2 : (pn >= 6 ? 1 : 0);
        const int pl = type == 2 ? pn - qtile0 : (type == 1 ? pn - 6 : pn), g = pl >> 1, h = 4 * (pl & 1) + wc;
        bf16_t* dstb = (bf16_t*)(wsb + (type == 0 ? WS_KB : (type == 1 ? WS_VB : WS_QB)));
        const int win = g == 0 ? 128 : (g == 1 ? 512 : 2048); float* kvo = outb + (g == 0 ? O_KV128P : (g == 1 ? O_KV512P : O_KV2048P));
        f32x4 g0 = {1.f, 1.f, 1.f, 1.f}, g1 = g0, g2 = g0, g3 = g0;
        if (type != 1) { const float* gp = (const float*)((const char*)kgain + (type == 0 ? 0l : qgain_delta)) + 16 * fq; const float sc = type == 2 ? qscale : 1.f;
            g0 = *(const f32x4*)gp * sc; g1 = *(const f32x4*)(gp + 4) * sc; g2 = *(const f32x4*)(gp + 8) * sc; g3 = *(const f32x4*)(gp + 12) * sc; }
        const int row0 = u.pm * BM + wr * 64 + fr, cbase = g * 512 + h * 64 + 16 * fq;
        float ssv[8];
#pragma unroll
        for (int e = 0; e < 8; ++e) ssv[e] = ss[row0 + (e >> 2) * HALF + (e & 3) * 16];
        f32x4 bc0 = {1.f, 1.f, 1.f, 1.f}, bc1 = bc0, bs0 = {0.f, 0.f, 0.f, 0.f}, bs1 = bs0;
        if (type != 1 && fq == 0) { const float* rp = rot + (size_t)(u.pm == 64 ? SEQ : (row0 & (SEQ - 1))) * 16;
            bc0 = *(const f32x4*)(rp); bc1 = *(const f32x4*)(rp + 4); bs0 = *(const f32x4*)(rp + 8); bs1 = *(const f32x4*)(rp + 12); }
#pragma unroll
        for (int ai = 0; ai < 2; ++ai)
#pragma unroll
            for (int m = 0; m < 4; ++m) {
                const int row = row0 + ai * HALF + m * 16; const bool smp = u.pm == 64; const int pos = smp ? SEQ : (row & (SEQ - 1)), b = smp ? row - SMP_ROW0 : (row >> 11);
                const float rs = __builtin_amdgcn_rsqf(ssv[4 * ai + m] * (1.f / DM) + NORM_EPS);
                f32x4 v0 = acc[ai][0][m][0] * rs, v1 = acc[ai][0][m][1] * rs, v2 = acc[ai][1][m][0] * rs, v3 = acc[ai][1][m][1] * rs;
                if (type != 1) {
                    const f32x4 q4 = v0 * v0 + v1 * v1 + v2 * v2 + v3 * v3; float sq = (q4[0] + q4[1]) + (q4[2] + q4[3]);
                    sq += shfl_xor_f(sq, 16); sq += shfl_xor_f(sq, 32);
                    const float inv = __builtin_amdgcn_rsqf(sq * (1.f / HD) + NORM_EPS);
                    v0 = v0 * inv * g0; v1 = v1 * inv * g1; v2 = v2 * inv * g2; v3 = v3 * inv * g3;
                    if (fq == 0) { const LAS float* dp = rotd + (smp ? 0 : (4 * ai + m) * 16);
                        const f32x4 dc0 = *(const LAS f32x4*)(dp), dc1 = *(const LAS f32x4*)(dp + 4), ds0 = *(const LAS f32x4*)(dp + 8), ds1 = *(const LAS f32x4*)(dp + 12);
                        const f32x4 c0 = bc0 * dc0 - bs0 * ds0, c1 = bc1 * dc1 - bs1 * ds1, s0 = bs0 * dc0 + bc0 * ds0, s1 = bs1 * dc1 + bc1 * ds1;
                        const f32x4 a0 = v0, a1 = v1, b0 = v2, b1 = v3;
                        v0 = a0 * c0 - b0 * s0; v1 = a1 * c1 - b1 * s1; v2 = b0 * c0 + a0 * s0; v3 = b1 * c1 + a1 * s1; }
                }
                if (smp) {
                    if (b >= 0 && b < NSMP) { float* d = (float*)(wsb + WS_SMP + (type == 0 ? SM_KN : (type == 1 ? SM_VN : SM_Q))) + (size_t)b * QW + cbase;
                        *(f32x4*)(d) = v0; *(f32x4*)(d + 4) = v1; *(f32x4*)(d + 8) = v2; *(f32x4*)(d + 12) = v3;
                        if (type != 2) { float* o = outb + (g == 0 ? O_KV128S : (g == 1 ? O_KV512S : O_KV2048S)) + ((size_t)b * 2 + type) * OW + h * 64 + 16 * fq;
                            *(f32x4*)(o) = v0; *(f32x4*)(o + 4) = v1; *(f32x4*)(o + 8) = v2; *(f32x4*)(o + 12) = v3; } }
                } else {
                    u32x4 w0, w1; w0.x = cvt_pk_bf16(v0[0], v0[1]); w0.y = cvt_pk_bf16(v0[2], v0[3]); w0.z = cvt_pk_bf16(v1[0], v1[1]); w0.w = cvt_pk_bf16(v1[2], v1[3]);
                    w1.x = cvt_pk_bf16(v2[0], v2[1]); w1.y = cvt_pk_bf16(v2[2], v2[3]); w1.z = cvt_pk_bf16(v3[0], v3[1]); w1.w = cvt_pk_bf16(v3[2], v3[3]);
                    bf16_t* d = dstb + (size_t)row * QW + cbase; *(u32x4*)d = w0; *(u32x4*)(d + 8) = w1;
                    if (type != 2) { const int rr = pos - (SEQ - win);
                        if (rr >= 0) { float* o = kvo + (((size_t)b * win + rr) * 2 + type) * OW + h * 64 + 16 * fq;
                            *(f32x4*)(o) = v0; *(f32x4*)(o + 4) = v1; *(f32x4*)(o + 8) = v2; *(f32x4*)(o + 12) = v3; } }
                }
                if (m & 1) asm volatile("" ::: "memory");
            }
    }
};
}
#define XB_TMO      128
#define XB_XCNT(j)  (256  + 64 * (j))
#define XB_XSUB(j)  (1280 + 64 * (j))
#define XB_XGEN(j)  (2304 + 64 * (j))
#define XB_TOP      3328
#define XB_TOPGEN   3392
#define XCD_BAR_WORDS 3456
#define XB_SPIN_CAP (1u << 18)

__device__ __forceinline__ unsigned xb_ld(unsigned* p)              { return __hip_atomic_load(p, __ATOMIC_RELAXED, __HIP_MEMORY_SCOPE_AGENT); }
__device__ __forceinline__ unsigned xb_add(unsigned* p, unsigned v) { return __hip_atomic_fetch_add(p, v, __ATOMIC_RELAXED, __HIP_MEMORY_SCOPE_AGENT); }
__device__ __forceinline__ unsigned xb_xcc_id() { return (unsigned)__builtin_amdgcn_s_getreg((3 << 11) | 20) & 0xFu; }
#define XB_SPIN(cond, bar) do { unsigned _sp = 0; while (cond) { __builtin_amdgcn_s_sleep(1); \
    if ((++_sp & 255u) == 0u) { if (xb_ld(&(bar)[XB_TMO])) break; if (_sp > XB_SPIN_CAP) { atomicAdd(&(bar)[XB_TMO], 1u); break; } } } } while (0)

struct XcdBarrier {
    unsigned* bar; unsigned x;
    volatile LAS unsigned* st;
};

__device__ __forceinline__ XcdBarrier xcd_barrier_post(unsigned* bar, volatile LAS unsigned* st) {
    XcdBarrier b; b.bar = bar; b.x = xb_xcc_id(); b.st = st;
    if (threadIdx.x == 0) (void)xb_add(&bar[XB_XCNT(b.x)], 1u);
    return b;
}
__device__ __forceinline__ void xcd_barrier_complete(unsigned* bar, unsigned x, unsigned& nloc, unsigned& nx) {
    const unsigned G = gridDim.x * gridDim.y * gridDim.z;
    unsigned sum, cnt, mine, sp = 0u;
    for (;;) {
        sum = 0u; cnt = 0u; mine = 0u;
#pragma unroll
        for (unsigned j = 0; j < 16; ++j) { const unsigned c = xb_ld(&bar[XB_XCNT(j)]); sum += c; cnt += (c > 0u) ? 1u : 0u; mine = (j == x) ? c : mine; }
        if (sum == G) break;
        __builtin_amdgcn_s_sleep(1);
        if ((++sp & 255u) == 0u) { if (xb_ld(&bar[XB_TMO])) break; if (sp > XB_SPIN_CAP) { atomicAdd(&bar[XB_TMO], 1u); break; } }
    }
    nloc = mine > 0u ? mine : 1u; nx = cnt > 0u ? cnt : 1u;
}

__device__ __forceinline__ void xcd_barrier(const XcdBarrier& b) {
    asm volatile("s_waitcnt vmcnt(0)" ::: "memory");
    __syncthreads();
    if (threadIdx.x == 0) {
        unsigned* bar = b.bar;
        __builtin_amdgcn_s_waitcnt(0);
        unsigned nloc = b.st[0], nx = b.st[1];
        if (nloc == 0u) { xcd_barrier_complete(bar, b.x, nloc, nx); b.st[0] = nloc; b.st[1] = nx; }
        const unsigned old = xb_add(&bar[XB_XSUB(b.x)], 1u);
        const unsigned gen = old / nloc;
        if (old + 1u == (gen + 1u) * nloc) {
            __builtin_amdgcn_fence(__ATOMIC_RELEASE, "agent");
            asm volatile("s_waitcnt vmcnt(0)" ::: "memory");
            const unsigned og = xb_add(&bar[XB_TOP], 1u);
            const unsigned tg = og / nx;
            if (og + 1u == (tg + 1u) * nx) xb_add(&bar[XB_TOPGEN], 1u);
            else XB_SPIN(xb_ld(&bar[XB_TOPGEN]) == tg, bar);
            __builtin_amdgcn_fence(__ATOMIC_ACQUIRE, "agent");
            xb_add(&bar[XB_XGEN(b.x)], 1u);
            asm volatile("s_waitcnt vmcnt(0)" ::: "memory");
        } else {
            XB_SPIN(xb_ld(&bar[XB_XGEN(b.x)]) == gen, bar);
            __builtin_amdgcn_fence(__ATOMIC_ACQUIRE, "agent");
            asm volatile("s_waitcnt vmcnt(0)" ::: "memory");
        }
    }
    __syncthreads();
}

struct Frame {
    LAS unsigned char* lds;
    volatile LAS unsigned* MISC;
    gu32* ctl; float* ctlf;
    int tid, lane, wave, vcu, G, bx;
    float* out; unsigned char* ws;
};
constexpr int PTAB_OFF = LDSCTL_OFF + 64;
__device__ __forceinline__ unsigned long long ptab_get(const Frame& F, int i) {
    const unsigned long long v = ((volatile LAS unsigned long long*)(F.lds + PTAB_OFF))[i];
    const unsigned lo = __builtin_amdgcn_readfirstlane((unsigned)v), hi = __builtin_amdgcn_readfirstlane((unsigned)(v >> 32));
    return ((unsigned long long)hi << 32) | lo;
}
__device__ __forceinline__ const float* inp(const Frame& F, int i) { return (const float*)(const GAS float*)ptab_get(F, i); }
__device__ __forceinline__ float* ptab_out(const Frame& F) { return (float*)(GAS float*)ptab_get(F, N_IN); }
__device__ __forceinline__ unsigned char* ptab_ws(const Frame& F) { return (unsigned char*)(GAS unsigned char*)ptab_get(F, N_IN + 1); }
__device__ __forceinline__ float* ssp(const Frame& F, int stage) { return F.ctlf + CW_SSP + stage * SS_STRIDE + SS_FRONT; }
__device__ __forceinline__ float* sss(const Frame& F, int stage) { return ssp(F, stage) + SMP_ROW0; }
__device__ __forceinline__ bf16_t* xsb_ptr(const Frame& F) { return (bf16_t*)(F.ws + WS_XB) + (XB_PAD_ROWS + SMP_ROW0) * DM; }

template <int RM> __device__ __forceinline__ int rowof(int n) {
    if (RM == 0) return n;
    if (RM == 1) { const int isb = n >= DFF ? 1 : 0; const int f = n - DFF * isb; return 256 * (f >> 7) + 128 * isb + (f & 127); }
    const int tile = n >> 8, hh = (n >> 6) & 3, e = n & 63; return 256 * tile + 128 * ((e >> 3) & 1) + 32 * hh + 8 * (e >> 4) + (e & 7);
}
struct WJob { const float* W; int K, ldw; bf16_t* WT; int row_off; const float* kscale; const float* nscale; int rm, kb, nb; };
constexpr int WT_UP = 16 * (DUP / 256), WT_DN = (DFF / 64) * (DM / 256), WT_KV = 16 * (KVW / 256), WT_Q = 16 * (QW / 256), WT_O = (OW / 64) * (DM / 256), WT_P = 8 * 4;
constexpr int WSEG0 = 0, WSEG1 = WT_P + WT_UP, WSEG2 = WSEG1 + 2 * WT_DN + WT_UP, WSEG2B = WSEG2 + WT_KV + WT_Q, WSEG3B = WSEG2B + 2 * WT_O + WT_UP + WT_DN + WT_Q, WSEG4 = WSEG3B + WT_UP + WT_DN;
__device__ __forceinline__ void wjob_up(const Frame& F, int l, int r, WJob& j) { const int nbk = DUP / 256;
    j.W = inp(F, IN_WUP) + (size_t)l * DM * DUP; j.K = DM; j.ldw = DUP; j.WT = (bf16_t*)(F.ws + WS_WUP) + (size_t)l * DUP * DM; j.kscale = inp(F, IN_GFFN) + l * DM; j.rm = 1; j.kb = r / nbk; j.nb = r % nbk; }
__device__ __forceinline__ void wjob_dn(const Frame& F, int l, int r, WJob& j) { const int nbk = DM / 256;
    j.W = inp(F, IN_WDOWN) + (size_t)l * DFF * DM; j.K = DFF; j.ldw = DM; j.WT = (bf16_t*)(F.ws + WS_WDOWN) + (size_t)l * DM * DFF; j.kb = r / nbk; j.nb = r % nbk; }
__device__ __forceinline__ void wjob_q(const Frame& F, int jj, int r, WJob& j) { const int nbk = QW / 256;
    j.W = inp(F, IN_WQ) + (size_t)jj * DM * QW; j.K = DM; j.ldw = QW; j.WT = jj == 0 ? (bf16_t*)(F.ws + WS_WKVQ) : (bf16_t*)(F.ws + WS_WQ3); j.row_off = jj == 0 ? KVW : 0; j.kscale = inp(F, IN_GATTN) + jj * DM; j.rm = 2;
    j.kb = r / nbk; j.nb = r % nbk; }
__device__ __forceinline__ void wjob_o(const Frame& F, int jj, int r, WJob& j) { const int nbk = DM / 256;
    j.W = inp(F, IN_WO) + (size_t)jj * OW * DM; j.K = OW; j.ldw = DM; j.WT = (bf16_t*)(F.ws + WS_WO) + (size_t)jj * DM * OW; j.kb = r / nbk; j.nb = r % nbk; }
__device__ __forceinline__ bool wjob_get(const Frame& F, int it, int it_end, WJob& j) {
    if (it >= it_end) return false;
    int r = it; j.row_off = 0; j.kscale = nullptr; j.nscale = nullptr; j.rm = 0;
    if (r < WT_P) { const int lg = r >> 2;
        j.W = inp(F, IN_WPOOL) + (size_t)lg * 65536; j.K = 256; j.ldw = 256; j.WT = (bf16_t*)(F.ws + WS_WP) + (size_t)lg * 65536; j.nscale = inp(F, IN_PSCALE) + lg * 256; j.kb = r & 3; j.nb = 0; return true; }
    r -= WT_P;
    if (r < WT_UP) { wjob_up(F, 0, r, j); return true; } r -= WT_UP;
    if (r < WT_DN) { wjob_dn(F, 0, r, j); return true; } r -= WT_DN;
    if (r < WT_UP) { wjob_up(F, 1, r, j); return true; } r -= WT_UP;
    if (r < WT_DN) { wjob_dn(F, 1, r, j); return true; } r -= WT_DN;
    if (r < WT_KV) { const int nbk = KVW / 256;
        j.W = inp(F, IN_WKV); j.K = DM; j.ldw = KVW; j.WT = (bf16_t*)(F.ws + WS_WKVQ); j.kscale = inp(F, IN_GKV); j.rm = 2; j.kb = r / nbk; j.nb = r % nbk; return true; }
    r -= WT_KV;
    if (r < WT_Q) { wjob_q(F, 0, r, j); return true; } r -= WT_Q;
    if (r < WT_O) { wjob_o(F, 0, r, j); return true; } r -= WT_O;
    if (r < WT_O) { wjob_o(F, 1, r, j); return true; } r -= WT_O;
    if (r < WT_UP) { wjob_up(F, 2, r, j); return true; } r -= WT_UP;
    if (r < WT_DN) { wjob_dn(F, 2, r, j); return true; } r -= WT_DN;
    if (r < WT_Q) { wjob_q(F, 1, r, j); return true; } r -= WT_Q;
    if (r < WT_UP) { wjob_up(F, 3, r, j); return true; } r -= WT_UP;
    wjob_dn(F, 3, r, j); return true;
}
__device__ __forceinline__ void wjob_load(const WJob& j, int wave, int lane, f32x4 (&v)[8]) {
#pragma unroll
    for (int i = 0; i < 8; ++i) v[i] = __builtin_nontemporal_load((const f32x4*)(j.W + (size_t)(64 * j.kb + 8 * wave + i) * j.ldw + 256 * j.nb + 4 * lane));
}
__device__ __forceinline__ void convert_weights(Frame& F, int it0, int it1, int cu_lo, int cu_hi = 1 << 30) {
    if (cu_hi > F.G) cu_hi = F.G;
    if (F.bx < cu_lo || F.bx >= cu_hi || it0 >= it1) return;
    LAS float* scr = (LAS float*)(F.lds + RING_OFF);
    const int stride = cu_hi - cu_lo;
    WJob cur, nxt; int it = it0 + (F.bx - cu_lo); bool have = wjob_get(F, it, it1, cur); f32x4 v[8];
    if (have) wjob_load(cur, F.wave, F.lane, v);
    while (have) {
        { const f32x4 ns = cur.nscale ? *(const f32x4*)(cur.nscale + 256 * cur.nb + 4 * F.lane) : (f32x4){1.f, 1.f, 1.f, 1.f};
#pragma unroll
            for (int i = 0; i < 8; ++i) { const int kk = 8 * F.wave + i; const float ks = cur.kscale ? cur.kscale[64 * cur.kb + kk] : 1.f; const f32x4 x = v[i] * ns * ks;
                LAS float* d = scr + kk * 257 + 4 * F.lane; d[0] = x[0]; d[1] = x[1]; d[2] = x[2]; d[3] = x[3]; } }
        __syncthreads();
        const bool more = wjob_get(F, it + stride, it1, nxt);
        if (more) wjob_load(nxt, F.wave, F.lane, v);
#pragma unroll
        for (int q = 0; q < 4; ++q) { const int id = F.tid + 512 * q, n = id >> 3, c = id & 7; const LAS float* s = scr + (8 * c) * 257 + n;
            u32x4 o; o.x = pk2(s[0 * 257], s[1 * 257]); o.y = pk2(s[2 * 257], s[3 * 257]); o.z = pk2(s[4 * 257], s[5 * 257]); o.w = pk2(s[6 * 257], s[7 * 257]);
            const int nl = 256 * cur.nb + n; const int row = cur.rm == 0 ? rowof<0>(nl) : (cur.rm == 1 ? rowof<1>(nl) : rowof<2>(nl));
            *(u32x4*)(cur.WT + (size_t)(cur.row_off + row) * cur.K + 64 * cur.kb + 8 * c) = o; }
        __syncthreads();
        cur = nxt; have = more; it += stride;
    }
}
__device__ __forceinline__ void p0_weights(Frame& F) {
    convert_weights(F, WSEG0, WSEG1, 0);
    float* rot = (float*)(F.ws + WS_ROT);
    if (F.wave == 0) { for (int e = F.vcu * 64 + F.lane; e < 2049 * 8; e += F.G * 64) { const int pos = e >> 3, i = e & 7;
        const double invf = i == 0 ? 1.0 : i == 1 ? 0.19392274474868576 : i == 2 ? 0.03760603093086393 : i == 3 ? 0.007292664737217109 : i == 4 ? 0.001414213562373095 : i == 5 ? 0.0002742481756762073 : i == 6 ? 5.318295896944988e-05 : 1.031338537721246e-05;
        const double ang = (double)pos * invf, n = __builtin_rint(ang * 0.15915494309189535);
        const double r = __builtin_fma(-n, 1.2246467991473532e-16 * 2.0, __builtin_fma(-n, 6.283185307179586, ang));
        const float rf = (float)r; rot[pos * 16 + i] = cosf(rf); rot[pos * 16 + 8 + i] = sinf(rf); } }
    { u32x4* xb = (u32x4*)(F.ws + WS_XB); const u32x4 z = {0u, 0u, 0u, 0u}; const size_t n0 = XB_PAD_ROWS * 128, n1 = XB_TAIL_ROWS * 128, tail = (XB_PAD_ROWS + MTOK) * 128;
        for (size_t i = (size_t)F.vcu * 512 + F.tid; i < n0 + n1; i += (size_t)F.G * 512) xb[i < n0 ? i : tail + (i - n0)] = z; }
}

template <bool XBF16> __device__ __forceinline__ f32x4 ld_x4(const void* x, size_t row, int col) {
    if (XBF16) { const u32x2 v = *(const u32x2*)((const bf16_t*)x + row * DM + col);
        return (f32x4){__builtin_bit_cast(float, v.x << 16), __builtin_bit_cast(float, v.x & 0xffff0000u), __builtin_bit_cast(float, v.y << 16), __builtin_bit_cast(float, v.y & 0xffff0000u)}; }
    return *(const f32x4*)((const float*)x + row * DM + col);
}
template <bool SELF_RSTD, bool XBF16>
__device__ __forceinline__ void pool_d_phase(Frame& F, const void* x, const float* ssin, const float* gpool, bf16_t* dbuf, float* pool_out) {
    LAS float* rs = (LAS float*)(F.lds + RING_OFF);
    for (int item = F.vcu; item < NBATCH * 32; item += F.G) {
        const int b = item >> 5, p0 = 64 * (item & 31); const size_t rowbase = (size_t)b * SEQ;
        if (SELF_RSTD) {
#pragma unroll
            for (int half = 0; half < 2; ++half) {
                f32x4 v[5][4];
#pragma unroll
                for (int jj = 0; jj < 5; ++jj) { const int i = F.wave + 8 * (5 * half + jj), p = p0 - 15 + i;
                    if (i < 79 && p >= 0) {
#pragma unroll
                        for (int j = 0; j < 4; ++j) v[jj][j] = ld_x4<XBF16>(x, rowbase + p, 4 * F.lane + 256 * j); } }
#pragma unroll
                for (int jj = 0; jj < 5; ++jj) { const int i = F.wave + 8 * (5 * half + jj), p = p0 - 15 + i;
                    if (i < 79 && p >= 0) { float s = 0.f;
#pragma unroll
                        for (int j = 0; j < 4; ++j) s += (v[jj][j][0] * v[jj][j][0] + v[jj][j][1] * v[jj][j][1]) + (v[jj][j][2] * v[jj][j][2] + v[jj][j][3] * v[jj][j][3]);
                        s = wave_sum(s); if (F.lane == 0) rs[i] = 1.0f / sqrtf(s * (1.f / DM) + NORM_EPS); } }
            }
        } else {
            if (F.tid < 79) { const int p = p0 - 15 + F.tid; if (p >= 0) rs[F.tid] = 1.0f / sqrtf(ssin[rowbase + p] * (1.f / DM) + NORM_EPS); }
        }
        __syncthreads();
        {
            const int q = F.tid >> 8, c4 = F.tid & 255, col = 4 * c4, w = 2 << (c4 >> 6), pstart = p0 + 32 * q, ro = p0 - 15;
            const f32x4 gp = *(const f32x4*)(gpool + col);
            f32x4 S = {0.f, 0.f, 0.f, 0.f};
            if (pstart == 0) {
#pragma unroll 1
                for (int i0 = 0; i0 < 32; i0 += 8) {
                    f32x4 xa[8], xo[8];
#pragma unroll
                    for (int k = 0; k < 8; ++k) { const int p = i0 + k; xa[k] = ld_x4<XBF16>(x, rowbase + p, col); xo[k] = ld_x4<XBF16>(x, rowbase + (p - w >= 0 ? p - w : 0), col); }
#pragma unroll
                    for (int k = 0; k < 8; ++k) { const int p = i0 + k; const f32x4 xn = xa[k] * rs[p - ro] * gp;
                        S += xn;
                        if (p - w >= 0) S -= xo[k] * rs[p - w - ro] * gp;
                        const int cnt = (p + 1) < w ? (p + 1) : w; const f32x4 d = S * (1.0f / (float)cnt) - xn;
                        u32x2 o; o.x = pk2(d[0], d[1]); o.y = pk2(d[2], d[3]); *(u32x2*)(dbuf + (rowbase + p) * DM + col) = o; }
                }
            } else {
                {
                    f32x4 xw[15];
#pragma unroll
                    for (int k = 0; k < 15; ++k) { xw[k] = (f32x4){0.f, 0.f, 0.f, 0.f}; if (15 - k <= w - 1) xw[k] = ld_x4<XBF16>(x, rowbase + pstart - 15 + k, col); }
#pragma unroll
                    for (int k = 0; k < 15; ++k) if (15 - k <= w - 1) S += xw[k] * rs[pstart - 15 + k - ro] * gp;
                }
                const float invw = 1.0f / (float)w;
#pragma unroll 1
                for (int i0 = 0; i0 < 32; i0 += 8) {
                    f32x4 xa[8], xo[8];
#pragma unroll
                    for (int k = 0; k < 8; ++k) { const int p = pstart + i0 + k; xa[k] = ld_x4<XBF16>(x, rowbase + p, col); xo[k] = ld_x4<XBF16>(x, rowbase + p - w, col); }
#pragma unroll
                    for (int k = 0; k < 8; ++k) { const int p = pstart + i0 + k; const f32x4 xn = xa[k] * rs[p - ro] * gp;
                        S += xn; if (i0 + k > 0) S -= xo[k] * rs[p - w - ro] * gp;
                        const f32x4 d = S * invw - xn;
                        u32x2 o; o.x = pk2(d[0], d[1]); o.y = pk2(d[2], d[3]); *(u32x2*)(dbuf + (rowbase + p) * DM + col) = o;
                        if (p >= SEQ - PHIST) *(f32x4*)(pool_out + ((size_t)b * PHIST + (p - (SEQ - PHIST))) * DM + col) = xn; }
                }
            }
        }
        __syncthreads();
    }
}

struct ALoadBf16 { const bf16_t* A; int lda; int acol0;
    __device__ __forceinline__ bf16x8 operator()(int row, int k) const { return *(const bf16x8*)(A + (size_t)row * lda + acol0 + k); } };
struct ALoadAttn { const float* op; const float* lp;
    __device__ __forceinline__ bf16x8 operator()(int row, int k) const {
        const int h = k >> 6; float l = 0.f; f32x4 a = {0.f, 0.f, 0.f, 0.f}, b = {0.f, 0.f, 0.f, 0.f};
#pragma unroll
        for (int g = 0; g < 6; ++g) { l += lp[(g * 128 + row) * 8 + h]; const float* p = op + ((size_t)g * 128 + row) * OW + k; a += *(const f32x4*)p; b += *(const f32x4*)(p + 4); }
        const float inv = 1.0f / l; a *= inv; b *= inv;
        u32x4 w; w.x = pk2(a[0], a[1]); w.y = pk2(a[2], a[3]); w.z = pk2(b[0], b[1]); w.w = pk2(b[2], b[3]); return __builtin_bit_cast(bf16x8, w); } };

template <int NT, int CH, class AL, class BRow, class Epi>
__device__ __forceinline__ void mini_gemm_item(Frame& F, const AL& al, const bf16_t* Bt, int K, const BRow& brow, int rb, const Epi& epi) {
    LAS float* red = (LAS float*)(F.lds + RING_OFF);
    const int w = F.wave, fr = F.lane & 15, fq = F.lane >> 4, ksub = K >> 3, k0 = w * ksub;
    f32x4 acc[2][NT]; int br[NT];
#pragma unroll
    for (int nt = 0; nt < NT; ++nt) { br[nt] = brow(16 * nt + fr); acc[0][nt] = (f32x4){0.f, 0.f, 0.f, 0.f}; acc[1][nt] = (f32x4){0.f, 0.f, 0.f, 0.f}; }
    constexpr int NQ_ = 4 * NT; const int tt_ = F.tid % (32 * NQ_);
    const auto pre = epi.prefetch(rb * 32 + tt_ / NQ_, 4 * (tt_ % NQ_));
    for (int kk0 = 0; kk0 < ksub; kk0 += 32 * CH) {
        bf16x8 a[CH][2], bb[CH][NT];
#pragma unroll
        for (int s = 0; s < CH; ++s) if (kk0 + 32 * s < ksub) {
#pragma unroll
            for (int mt = 0; mt < 2; ++mt) a[s][mt] = al(rb * 32 + 16 * mt + fr, k0 + kk0 + 32 * s + 8 * fq);
#pragma unroll
            for (int nt = 0; nt < NT; ++nt) bb[s][nt] = *(const bf16x8*)(Bt + (size_t)br[nt] * K + k0 + kk0 + 32 * s + 8 * fq); }
#pragma unroll
        for (int s = 0; s < CH; ++s) if (kk0 + 32 * s < ksub) {
#pragma unroll
            for (int mt = 0; mt < 2; ++mt)
#pragma unroll
                for (int nt = 0; nt < NT; ++nt) acc[mt][nt] = __builtin_amdgcn_mfma_f32_16x16x32_bf16(a[s][mt], bb[s][nt], acc[mt][nt], 0, 0, 0); }
    }
#pragma unroll
    for (int mt = 0; mt < 2; ++mt)
#pragma unroll
        for (int nt = 0; nt < NT; ++nt)
#pragma unroll
            for (int i = 0; i < 4; ++i) red[(w * 32 + 16 * mt + 4 * fq + i) * (16 * NT) + 16 * nt + fr] = acc[mt][nt][i];
    __syncthreads();
    constexpr int NQ = 4 * NT;
    {
        const int t = F.tid % (32 * NQ); const bool live = F.tid < 32 * NQ; const int row = t / NQ, cq = t % NQ; f32x4 s = {0.f, 0.f, 0.f, 0.f};
#pragma unroll
        for (int w8 = 0; w8 < 8; ++w8) s += *(const LAS f32x4*)(red + (w8 * 32 + row) * (16 * NT) + 4 * cq);
        epi(rb * 32 + row, 4 * cq, s, live, pre);
    }
    __syncthreads();
}
template <int NQ> __device__ __forceinline__ float rowred(float v) {
#pragma unroll
    for (int o = 1; o < NQ; o <<= 1) v += shfl_xor_f(v, o);
    return v;
}
template <int NQ> struct SmpResid { const float* xin; float* xout; bf16_t* xb; float* ss; int c0;
    __device__ __forceinline__ f32x4 prefetch(int row, int jj0) const { return *(const f32x4*)(xin + (size_t)row * DM + c0 + jj0); }
    __device__ __forceinline__ void operator()(int row, int jj0, f32x4 s, bool live, f32x4 xold) const {
        const size_t off = (size_t)row * DM + c0 + jj0; const f32x4 v = xold + s;
        if (live) { *(f32x4*)(xout + off) = v; u32x2 o; o.x = pk2(v[0], v[1]); o.y = pk2(v[2], v[3]); *(u32x2*)(xb + off) = o; }
        const float q = rowred<NQ>((v[0] * v[0] + v[1] * v[1]) + (v[2] * v[2] + v[3] * v[3]));
        if (live && ss && (jj0 == 0)) unsafeAtomicAdd(ss + row, q); } };
struct BRowNat { int r0; __device__ __forceinline__ int operator()(int jj) const { return r0 + jj; } };

__device__ __forceinline__ void smp_pool_d(Frame& F, int layer, const float* xs, bool self_rstd, const float* ssin) {
    const int gwr = (F.G - 1 - F.bx) * NWAVES + F.wave, NGW = F.G * NWAVES;
    const float* gpool = inp(F, IN_GPOOL) + layer * DM; bf16_t* ds = (bf16_t*)(F.ws + WS_SMP + SM_DS);
    const float* spool = inp(F, IN_SPOOL);
    for (int task = gwr; task < NSMP * 4; task += NGW) { const int b = task >> 2, j = task & 3;
        const int col = 256 * j + 4 * F.lane, w = 2 << j;
        const float* hist = spool + ((size_t)layer * NSMP + b) * PHIST * DM + col; float* po = F.out + O_POOLS + ((size_t)layer * NSMP + b) * PHIST * DM + col;
        const f32x4* xr = (const f32x4*)(xs + (size_t)b * DM) + F.lane; f32x4 v[4], hv[PHIST];
#pragma unroll
        for (int jj = 0; jj < 4; ++jj) v[jj] = xr[64 * jj];
#pragma unroll
        for (int i = 0; i < PHIST; ++i) hv[i] = *(const f32x4*)(hist + (size_t)i * DM);
        float s = 0.f;
#pragma unroll
        for (int jj = 0; jj < 4; ++jj) s += (v[jj][0] * v[jj][0] + v[jj][1] * v[jj][1]) + (v[jj][2] * v[jj][2] + v[jj][3] * v[jj][3]);
        s = self_rstd ? wave_sum(s) : ssin[b];
        const float r = 1.0f / sqrtf(s * (1.f / DM) + NORM_EPS);
        const f32x4 xj = j == 0 ? v[0] : (j == 1 ? v[1] : (j == 2 ? v[2] : v[3]));
        const f32x4 xn = xj * r * *(const f32x4*)(gpool + col); f32x4 S = xn;
#pragma unroll
        for (int i = 0; i < PHIST; ++i) { if (i >= PHIST - (w - 1)) S += hv[i]; if (i >= 1) *(f32x4*)(po + (size_t)(i - 1) * DM) = hv[i]; }
        *(f32x4*)(po + (size_t)(PHIST - 1) * DM) = xn;
        const f32x4 d = S * (1.0f / (float)w) - xn; u32x2 o; o.x = pk2(d[0], d[1]); o.y = pk2(d[2], d[3]); *(u32x2*)(ds + (size_t)b * DM + col) = o;
    }
}
struct ALoadBf16Coh { const bf16_t* A; int lda;
    __device__ __forceinline__ bf16x8 operator()(int row, int k) const { unsigned long long* p = (unsigned long long*)(A + (size_t)row * lda + k);
        const unsigned long long lo = __hip_atomic_load(p, RLX_AGENT), hi = __hip_atomic_load(p + 1, RLX_AGENT);
        const u32x4 w = {(unsigned)lo, (unsigned)(lo >> 32), (unsigned)hi, (unsigned)(hi >> 32)}; return __builtin_bit_cast(bf16x8, w); } };
__device__ __forceinline__ void smp_attn_finalize(Frame& F, int layer) {
    if (F.wave != 0) return;
    const float* op = (const float*)(F.ws + WS_SMP + SM_OP); const float* lp = (const float*)(F.ws + WS_SMP + SM_LP); bf16_t* oa = (bf16_t*)(F.ws + WS_SMP + SM_OA);
    for (int task = F.bx; task < 2 * NSMP; task += F.G) { const int row = task >> 1, col = 256 * (task & 1) + 4 * F.lane, h = col >> 6;
        float l = 0.f; f32x4 a = {0.f, 0.f, 0.f, 0.f};
#pragma unroll
        for (int g = 0; g < 6; ++g) { l += lp[(g * 128 + row) * 8 + h]; a += *(const f32x4*)(op + ((size_t)g * 128 + row) * OW + col); }
        a *= 1.0f / l;
        const unsigned long long w = (unsigned long long)pk2(a[0], a[1]) | ((unsigned long long)pk2(a[2], a[3]) << 32);
        __hip_atomic_store((unsigned long long*)(oa + (size_t)row * OW + col), w, RLX_AGENT);
        asm volatile("s_waitcnt vmcnt(0)" ::: "memory");
        if (F.lane == 0) __hip_atomic_fetch_add((unsigned*)F.ctl + CW_SUB + layer, 1u, RLX_AGENT);
    }
}
__device__ __forceinline__ void smp_mixer_gemm(Frame& F, int layer, const float* xin, float* xout, float* ssout) {
    bf16_t* xsb = xsb_ptr(F);
    for (int it = F.G - 1 - F.bx; it < 4 * 64; it += F.G) { const int rb = it & 3, cb = it >> 2;
        const SmpResid<4> E{xin, xout, xsb, ssout, 16 * cb};
        if (layer < 2) { const int grp = cb >> 4; const ALoadBf16 al{(const bf16_t*)(F.ws + WS_SMP + SM_DS), DM, 256 * grp};
            mini_gemm_item<1, 12>(F, al, (const bf16_t*)(F.ws + WS_WP) + (size_t)layer * 4 * 65536, 256, BRowNat{16 * cb}, rb, E); }
        else { if (F.tid == 0) { unsigned* ctr = (unsigned*)F.ctl + CW_SUB + layer; unsigned* bar = (unsigned*)F.ctl + CW_BAR; XB_SPIN(xb_ld(ctr) < 2u * NSMP, bar); }
            __syncthreads();
            const ALoadBf16Coh al{(const bf16_t*)(F.ws + WS_SMP + SM_OA), OW};
            mini_gemm_item<1, 12>(F, al, (const bf16_t*)(F.ws + WS_WO) + (size_t)(layer - 2) * DM * OW, OW, BRowNat{16 * cb}, rb, E); }
    }
}
struct BRowUp { int f0; __device__ __forceinline__ int operator()(int jj) const { return rowof<1>((jj & 1) * DFF + f0 + (jj >> 1)); } };
struct SmpUpPre { f32x2 h0a, h1a, h0b, h1b, w0a, w1a, w2a, w0b, w1b, w2b, ba, bb; float ssv; };
struct SmpUp { const float* ss; const float* cw; const float* cb; const float* hist; float* convs; bf16_t* act; int f0;
    __device__ __forceinline__ SmpUpPre prefetch(int row, int jj0) const { SmpUpPre p; const int fa = f0 + (jj0 >> 1), fb = fa + DFF;
        p.h0a = *(const f32x2*)(hist + (size_t)(row * 2 + 0) * DUP + fa); p.h1a = *(const f32x2*)(hist + (size_t)(row * 2 + 1) * DUP + fa);
        p.h0b = *(const f32x2*)(hist + (size_t)(row * 2 + 0) * DUP + fb); p.h1b = *(const f32x2*)(hist + (size_t)(row * 2 + 1) * DUP + fb);
        p.w0a = *(const f32x2*)(cw + fa); p.w1a = *(const f32x2*)(cw + DUP + fa); p.w2a = *(const f32x2*)(cw + 2 * DUP + fa);
        p.w0b = *(const f32x2*)(cw + fb); p.w1b = *(const f32x2*)(cw + DUP + fb); p.w2b = *(const f32x2*)(cw + 2 * DUP + fb);
        p.ba = *(const f32x2*)(cb + fa); p.bb = *(const f32x2*)(cb + fb); p.ssv = ss[row]; return p; }
    __device__ __forceinline__ void operator()(int row, int jj0, f32x4 s, bool live, const SmpUpPre& p) const {
        if (!live) return;
        const float rs = 1.0f / sqrtf(p.ssv * (1.f / DM) + NORM_EPS); const int f = f0 + (jj0 >> 1);
        const f32x2 ua = (f32x2){s[0], s[2]} * rs, ub = (f32x2){s[1], s[3]} * rs;
        const f32x2 ca = p.ba + p.w0a * p.h0a + p.w1a * p.h1a + p.w2a * ua, cv = p.bb + p.w0b * p.h0b + p.w1b * p.h1b + p.w2b * ub;
        const float r0 = ca[0] / (1.f + __expf(-ca[0])) * cv[0], r1 = ca[1] / (1.f + __expf(-ca[1])) * cv[1];
        *(f32x2*)(convs + (size_t)(row * 2 + 0) * DUP + f) = p.h1a; *(f32x2*)(convs + (size_t)(row * 2 + 1) * DUP + f) = ua;
        *(f32x2*)(convs + (size_t)(row * 2 + 0) * DUP + f + DFF) = p.h1b; *(f32x2*)(convs + (size_t)(row * 2 + 1) * DUP + f + DFF) = ub;
        *(unsigned*)(act + (size_t)row * DFF + f) = pk2(r0, r1); } };
__device__ __forceinline__ void smp_up(Frame& F, int layer, const float* ssin) {
    for (int it = F.G - 1 - F.bx; it < 4 * (DFF / 32); it += F.G) { const int rb = it & 3, cb = it >> 2;
        const ALoadBf16 al{xsb_ptr(F), DM, 0};
        const SmpUp E{ssin, inp(F, IN_CONVW) + (size_t)layer * 3 * DUP, inp(F, IN_CONVB) + (size_t)layer * DUP, inp(F, IN_SCONV) + (size_t)layer * NSMP * 2 * DUP,
                      F.out + O_CONVS + (size_t)layer * NSMP * 2 * DUP, (bf16_t*)(F.ws + WS_SMP + SM_ACT), 32 * cb};
        mini_gemm_item<4, 4>(F, al, (const bf16_t*)(F.ws + WS_WUP) + (size_t)layer * DUP * DM, DM, BRowUp{32 * cb}, rb, E); }
}
__device__ __forceinline__ void smp_down(Frame& F, int layer, const float* xin, float* xout, float* ssout) {
    for (int it = F.G - 1 - F.bx; it < 4 * 64; it += F.G) { const int rb = it & 3, cb = it >> 2;
        const ALoadBf16 al{(const bf16_t*)(F.ws + WS_SMP + SM_ACT), DFF, 0};
        const SmpResid<4> E{xin, xout, xsb_ptr(F), ssout, 16 * cb};
        mini_gemm_item<1, 12>(F, al, (const bf16_t*)(F.ws + WS_WDOWN) + (size_t)layer * DM * DFF, DFF, BRowNat{16 * cb}, rb, E); }
}
struct BRowHead { int base; __device__ __forceinline__ int operator()(int jj) const { return base + 128 * (jj >> 5) + (jj & 31); } };
struct SmpQKV { const float* ss; const float* rot; const float* gain; float scale; int type; float* dst; float* kvo; int hcol;
    __device__ __forceinline__ int prefetch(int, int) const { return 0; }
    __device__ __forceinline__ void operator()(int row, int jj0, f32x4 s, bool live, int) const {
        const float rs = 1.0f / sqrtf(ss[row] * (1.f / DM) + NORM_EPS); const int bj = jj0 >> 5, r0 = jj0 & 31, d0 = 16 * (r0 >> 3) + 8 * bj + (r0 & 7);
        f32x4 v = s * rs;
        if (type != 1) {
            const float sq = rowred<16>((v[0] * v[0] + v[1] * v[1]) + (v[2] * v[2] + v[3] * v[3])); const float inv = 1.0f / sqrtf(sq * (1.f / HD) + NORM_EPS);
            v = v * inv * *(const f32x4*)(gain + d0);
            f32x4 pv; pv[0] = shfl_xor_f(v[0], 8); pv[1] = shfl_xor_f(v[1], 8); pv[2] = shfl_xor_f(v[2], 8); pv[3] = shfl_xor_f(v[3], 8);
            if (r0 < 8) { const float* rp = rot + (size_t)SEQ * 16 + (r0 & 7); const f32x4 c = *(const f32x4*)rp, sn = *(const f32x4*)(rp + 8);
                v = bj == 0 ? v * c - pv * sn : v * c + pv * sn; }
            v *= scale;
        }
        if (live) { *(f32x4*)(dst + (size_t)row * QW + hcol + d0) = v; if (kvo) *(f32x4*)(kvo + ((size_t)row * 2 + type) * OW + d0) = v; } } };
__device__ __forceinline__ void smp_qkv(Frame& F, int layer, const float* ssin) {
    const int nhead = layer == 2 ? 72 : 24;
    const bf16_t* W = layer == 2 ? (const bf16_t*)(F.ws + WS_WKVQ) : (const bf16_t*)(F.ws + WS_WQ3);
    const float* rot = (const float*)(F.ws + WS_ROT);
    for (int it = F.G - 1 - F.bx; it < 4 * nhead; it += F.G) { const int rb = it & 3, hd = it >> 2;
        const int tile = hd >> 2, hh = hd & 3; const int type = layer == 2 ? (tile >= 12 ? 2 : (tile >= 6 ? 1 : 0)) : 2;
        const int pl = layer == 2 ? (type == 2 ? tile - 12 : (type == 1 ? tile - 6 : tile)) : tile; const int g = pl >> 1, h = 4 * (pl & 1) + hh;
        const ALoadBf16 al{xsb_ptr(F), DM, 0};
        float* dst = (float*)(F.ws + WS_SMP + (type == 0 ? SM_KN : (type == 1 ? SM_VN : SM_Q)));
        float* kvo = type == 2 ? nullptr : F.out + (g == 0 ? O_KV128S : (g == 1 ? O_KV512S : O_KV2048S)) + h * 64;
        const SmpQKV E{ssin, rot, type == 0 ? inp(F, IN_KGAIN) : inp(F, IN_QGAIN) + (layer - 2) * HD, type == 2 ? 0.125f * LOG2E : 1.f, type, dst, kvo, g * 512 + h * 64};
        mini_gemm_item<4, 4>(F, al, W, DM, BRowHead{256 * tile + 32 * hh}, rb, E); }
}
__device__ __forceinline__ float softmax_offset(const Frame& F, int j) {
    const float a = fabsf(inp(F, IN_QGAIN)[j * HD + F.lane]), b = fabsf(inp(F, IN_KGAIN)[F.lane]); float ma = a, mb = b;
#pragma unroll
    for (int o = 1; o < 64; o <<= 1) { ma = fmaxf(ma, shfl_xor_f(ma, o)); mb = fmaxf(mb, shfl_xor_f(mb, o)); }
    return 8.0f * ma * mb * LOG2E;
}
__device__ __forceinline__ void smp_attn(Frame& F, int j) {
    LAS float* red = (LAS float*)(F.lds + RING_OFF);
    const float m0 = softmax_offset(F, j);
    const float* qs = (const float*)(F.ws + WS_SMP + SM_Q); const float* kn = (const float*)(F.ws + WS_SMP + SM_KN); const float* vn = (const float*)(F.ws + WS_SMP + SM_VN);
    float* op = (float*)(F.ws + WS_SMP + SM_OP); float* lp = (float*)(F.ws + WS_SMP + SM_LP);
    for (int it = F.G - 1 - F.bx; it < NSMP * 3; it += F.G) { const int b = it / 3, g = it % 3;
        const int dil = g == 0 ? 1 : (g == 1 ? 4 : 16), nbuf = g == 0 ? 128 : (g == 1 ? 512 : 2048);
        const float* c0p = inp(F, IN_C128); const float* c1p = inp(F, IN_C512); const float* c2p = inp(F, IN_C2048);
        const float* cache = (g == 0 ? c0p : (g == 1 ? c1p : c2p)) + (size_t)b * nbuf * 1024;
        f32x4 q[2], o[2]; float ls[2] = {0.f, 0.f};
#pragma unroll
        for (int jj = 0; jj < 2; ++jj) { q[jj] = *(const f32x4*)(qs + (size_t)b * QW + g * 512 + 256 * jj + 4 * F.lane); o[jj] = (f32x4){0.f, 0.f, 0.f, 0.f}; }
        for (int kq = F.wave * 16; kq < F.wave * 16 + 16; kq += 4) {
            f32x4 kv[4][4];
#pragma unroll
            for (int r = 0; r < 4; ++r) { const f32x4* rowp = (const f32x4*)(cache + (size_t)(kq + r) * dil * 1024) + F.lane;
#pragma unroll
                for (int c = 0; c < 4; ++c) kv[r][c] = __builtin_nontemporal_load(rowp + 64 * c); }
#pragma unroll
            for (int r = 0; r < 4; ++r)
#pragma unroll
                for (int jj = 0; jj < 2; ++jj) { const f32x4 k = kv[r][jj]; float s = (k[0] * q[jj][0] + k[1] * q[jj][1]) + (k[2] * q[jj][2] + k[3] * q[jj][3]);
                    s = rowred<16>(s); const float p = __builtin_amdgcn_exp2f(s - m0); ls[jj] += p; o[jj] += kv[r][2 + jj] * p; }
        }
        if (F.wave == 0) {
#pragma unroll
            for (int jj = 0; jj < 2; ++jj) { const f32x4 k = *(const f32x4*)(kn + (size_t)b * QW + g * 512 + 256 * jj + 4 * F.lane), v = *(const f32x4*)(vn + (size_t)b * QW + g * 512 + 256 * jj + 4 * F.lane);
                float s = (k[0] * q[jj][0] + k[1] * q[jj][1]) + (k[2] * q[jj][2] + k[3] * q[jj][3]); s = rowred<16>(s); const float p = __builtin_amdgcn_exp2f(s - m0); ls[jj] += p; o[jj] += v * p; }
        }
#pragma unroll
        for (int jj = 0; jj < 2; ++jj) { *(LAS f32x4*)(red + F.wave * 576 + 256 * jj + 4 * F.lane) = o[jj]; if ((F.lane & 15) == 0) red[F.wave * 576 + 512 + 4 * jj + (F.lane >> 4)] = ls[jj]; }
        __syncthreads();
        for (int e = F.tid; e < 520; e += 512) { float s = 0.f;
#pragma unroll
            for (int w8 = 0; w8 < 8; ++w8) s += red[w8 * 576 + e];
            if (e < 512) op[((size_t)g * NSMP + b) * OW + e] = s; else lp[((size_t)g * NSMP + b) * 8 + (e - 512)] = s; }
        __syncthreads();
    }
}

namespace att {
constexpr int ROWB = 128, BUFB = 256 * ROWB;
constexpr int SRED_OFF = RING_BYTES + 1024;
typedef short v4i16_t __attribute__((ext_vector_type(4)));
__device__ __forceinline__ s16x4 vtr(LAS const unsigned char* p) { return __builtin_bit_cast(s16x4, __builtin_amdgcn_ds_read_tr16_b64_v4i16((LAS v4i16_t*)p)); }
__device__ __forceinline__ int k_off(int buf) { return buf == 0 ? 0 : 3 * BUFB; }
__device__ __forceinline__ int v_off(int buf) { return buf == 0 ? BUFB : 2 * BUFB; }

__device__ __forceinline__ void wave_task(LAS const unsigned char* kb, LAS const unsigned char* vb, const bf16x8 (&qf)[2], int krw, int c_lo, int c_hi, int lo, int hi, int kmin, float m0, f32x4 (&O)[4], float& lsum, int lane) {
    const int fr = lane & 15, fq = lane >> 4;
    const f32x4 cinit = {-m0, -m0, -m0, -m0};
    int koff[2][2], voff[4][2];
#pragma unroll
    for (int t = 0; t < 2; ++t)
#pragma unroll
        for (int ks = 0; ks < 2; ++ks) koff[t][ks] = ((fq + 4 * ks) ^ ((fr & 3) + 4 * t)) << 4;
#pragma unroll
    for (int dt = 0; dt < 4; ++dt)
#pragma unroll
        for (int hf = 0; hf < 2; ++hf) voff[dt][hf] = (((2 * dt + ((fr & 3) >> 1)) ^ ((fr >> 2) + 4 * hf)) << 4) + 8 * (fr & 1);
    if (c_lo >= c_hi) return;
    const unsigned vbase = (unsigned)(__UINTPTR_TYPE__)vb + (unsigned)((krw + 8 * fq + (fr >> 2)) * ROWB);
    const int krowb = krw + 8 * (fr >> 2) + (fr & 3);
    bf16x8 kf[2][2];
#pragma unroll
    for (int t = 0; t < 2; ++t)
#pragma unroll
        for (int ks = 0; ks < 2; ++ks) kf[t][ks] = *(const LAS bf16x8*)(kb + (krowb + 32 * c_lo + 4 * t) * ROWB + koff[t][ks]);
    for (int c = c_lo; c < c_hi; ++c) {
        const unsigned va = vbase + (unsigned)(32 * c * ROWB);
        s16x4 vlo[4], vhi[4];
#pragma unroll
        for (int dt = 0; dt < 4; ++dt) {
            asm volatile("ds_read_b64_tr_b16 %0, %1" : "=&v"(vlo[dt]) : "v"(va + (unsigned)voff[dt][0]) : "memory");
            asm volatile("ds_read_b64_tr_b16 %0, %1" : "=&v"(vhi[dt]) : "v"(va + (unsigned)(4 * ROWB + voff[dt][1])) : "memory"); }
        f32x4 S[2];
#pragma unroll
        for (int t = 0; t < 2; ++t) { S[t] = __builtin_amdgcn_mfma_f32_16x16x32_bf16(kf[t][0], qf[0], cinit, 0, 0, 0); S[t] = __builtin_amdgcn_mfma_f32_16x16x32_bf16(kf[t][1], qf[1], S[t], 0, 0, 0); }
        { const int cn = c + 1 < c_hi ? c + 1 : c;
#pragma unroll
            for (int t = 0; t < 2; ++t)
#pragma unroll
                for (int ks = 0; ks < 2; ++ks) kf[t][ks] = *(const LAS bf16x8*)(kb + (krowb + 32 * cn + 4 * t) * ROWB + koff[t][ks]); }
        float p[8];
#pragma unroll
        for (int t = 0; t < 2; ++t)
#pragma unroll
            for (int i = 0; i < 4; ++i) { const int kk = 32 * c + 8 * fq + 4 * t + i, dlt = kk - fr; const bool ok = dlt >= lo && dlt <= hi && kk >= kmin;
                const float e = __builtin_amdgcn_exp2f(S[t][i]); p[4 * t + i] = ok ? e : 0.f; lsum += p[4 * t + i]; }
        u32x4 pw; pw.x = cvt_pk_bf16(p[0], p[1]); pw.y = cvt_pk_bf16(p[2], p[3]); pw.z = cvt_pk_bf16(p[4], p[5]); pw.w = cvt_pk_bf16(p[6], p[7]);
        const bf16x8 pb = __builtin_bit_cast(bf16x8, pw);
        asm volatile("s_waitcnt lgkmcnt(0)" ::: "memory"); __builtin_amdgcn_sched_barrier(0);
#pragma unroll
        for (int dt = 0; dt < 4; ++dt) {
            const bf16x8 vf = {vlo[dt][0], vlo[dt][1], vlo[dt][2], vlo[dt][3], vhi[dt][0], vhi[dt][1], vhi[dt][2], vhi[dt][3]};
            O[dt] = __builtin_amdgcn_mfma_f32_16x16x32_bf16(vf, pb, O[dt], 0, 0, 0);
        }
    }
}
struct Pass { int g, ps, s, nsub; bool first, last;
    int hc, tok0, nlo_shift, step_hi, step_lo, krvalid0; };
__device__ __forceinline__ Pass pass_desc(int P, int jq, int h) {
    Pass d; d.nsub = 1; d.s = 0; d.first = true; d.last = true;
    if (P < 8) { d.g = P >> 2; d.ps = P & 3; const int dil = d.g == 0 ? 1 : 4, r = d.g == 0 ? 0 : d.ps, l0 = d.g == 0 ? 512 * jq + 128 * d.ps : 128 * jq;
        d.hc = d.g * 512 + h * 64; d.tok0 = (l0 - 128) * dil + r; d.nlo_shift = 8; d.step_hi = 0; d.step_lo = dil; d.krvalid0 = l0 >= 128 ? 0 : 128; }
    else { d.g = 2; d.nsub = (32 * jq + 32 > 64) ? 2 : 1; const int q = P - 8; d.ps = d.nsub == 2 ? (q >> 1) : q; d.s = d.nsub == 2 ? (q & 1) : 0; d.first = d.s == 0; d.last = d.s == d.nsub - 1;
        d.hc = 2 * 512 + h * 64; d.tok0 = 16 * 64 * d.s + 4 * d.ps; d.nlo_shift = 6; d.step_hi = 1; d.step_lo = 16; d.krvalid0 = 0; }
    return d;
}
__device__ __forceinline__ void stage_dma(LAS unsigned char* lds, const Pass& d, int buf, const bf16_t* Kb, const bf16_t* Vb, const bf16_t* zrow, size_t rowbase, int w, int lane) {
    const int ch = (lane & 7) ^ (lane >> 3);
#pragma unroll
    for (int it = 0; it < 4; ++it) { const int kr0 = 64 * it + 8 * w, kr = kr0 + (lane >> 3);
        const int tok = d.tok0 + (kr >> d.nlo_shift) * d.step_hi + (kr & ((1 << d.nlo_shift) - 1)) * d.step_lo;
        const size_t off = (rowbase + tok) * QW + d.hc + 8 * ch; const bool ok = kr >= d.krvalid0;
        const bf16_t* ks = ok ? Kb + off : zrow + 8 * ch; const bf16_t* vs = ok ? Vb + off : zrow + 8 * ch;
        __builtin_amdgcn_global_load_lds((const unsigned*)ks, (LAS unsigned*)(lds + k_off(buf) + kr0 * ROWB), 16, 0, 0);
        __builtin_amdgcn_global_load_lds((const unsigned*)vs, (LAS unsigned*)(lds + v_off(buf) + kr0 * ROWB), 16, 0, 0); }
}
__device__ __forceinline__ int task_qtok(const Pass& d, int jq, int w, int fr) {
    if (d.g < 2) { const int dil = d.g == 0 ? 1 : 4, r = d.g == 0 ? 0 : d.ps, l0 = d.g == 0 ? 512 * jq + 128 * d.ps : 128 * jq; return (l0 + 16 * w + fr) * dil + r; }
    return 16 * (32 * jq + 16 * (w & 1) + fr) + 4 * d.ps + (w >> 1);
}

__device__ __forceinline__ void phase(Frame& F, int j) {
    LAS unsigned char* lds = F.lds + RING_OFF;
    LAS float* sred = (LAS float*)(F.lds + SRED_OFF);
    const float m0 = softmax_offset(F, j);
    const bf16_t* Qb = (const bf16_t*)(F.ws + WS_QB); const bf16_t* Kb = (const bf16_t*)(F.ws + WS_KB); const bf16_t* Vb = (const bf16_t*)(F.ws + WS_VB); bf16_t* Ob = (bf16_t*)(F.ws + WS_OB);
    const bf16_t* zrow = (const bf16_t*)(F.ws + WS_XB);
    bf16_t* opart = (bf16_t*)(F.ws + WS_OPART);
    float* lpart = (float*)(F.ws + WS_LPART);
    const float* qs = (const float*)(F.ws + WS_SMP + SM_Q); const float* kn = (const float*)(F.ws + WS_SMP + SM_KN); const float* vn = (const float*)(F.ws + WS_SMP + SM_VN);
    float* sop = (float*)(F.ws + WS_SMP + SM_OP); float* slp = (float*)(F.ws + WS_SMP + SM_LP);
    const float* c0p = inp(F, IN_C128); const float* c1p = inp(F, IN_C512); const float* c2p = inp(F, IN_C2048);
    const int lane = F.lane, fr = lane & 15, fq = lane >> 4, w = F.wave;
    for (int i = F.tid; i < 16 * ROWB / 4; i += 512) { ((LAS unsigned*)(lds + v_off(1)))[i] = 0u; ((LAS unsigned*)(lds + k_off(1)))[i] = 0u; }
    for (int unit = F.vcu; unit < 256; unit += F.G) {
        const int b = unit >> 5, h = (unit >> 2) & 7, jq = unit & 3; const size_t rowbase = (size_t)b * SEQ;
        const int np = 8 + 4 * ((32 * jq + 32 > 64) ? 2 : 1);
        const int hi0 = 3 * unit; constexpr int n_sl = 12;
        f32x4 sq[2], so[2]; float sl_[2] = {0.f, 0.f};
        so[0] = (f32x4){0.f, 0.f, 0.f, 0.f}; so[1] = so[0]; sq[0] = so[0]; sq[1] = so[0];
        bf16x8 qn[2];
        { const Pass d0 = pass_desc(0, jq, h); stage_dma(lds, d0, 0, Kb, Vb, zrow, rowbase, w, lane);
            const bf16_t* qp = Qb + (rowbase + task_qtok(d0, jq, w, fr)) * QW + d0.hc + 8 * fq; qn[0] = *(const bf16x8*)qp; qn[1] = *(const bf16x8*)(qp + 32);
        }
        __syncthreads();
        f32x4 O[4]; float lsum = 0.f; bf16x8 qf[2];
        f32x4 Opend[4]; float lpend = 0.f; size_t ppend = 0; bool pend = false;
#define ATT_FLUSH() do { if (pend) { bf16_t* op_ = opart + ppend * OW + h * 64 + 4 * fq; \
            _Pragma("unroll") for (int dt = 0; dt < 4; ++dt) { u32x2 pw_; pw_.x = cvt_pk_bf16(Opend[dt][0], Opend[dt][1]); pw_.y = cvt_pk_bf16(Opend[dt][2], Opend[dt][3]); *(u32x2*)(op_ + 16 * dt) = pw_; } \
            if (fq == 0) lpart[ppend * 8 + h] = lpend; pend = false; } } while (0)
        for (int P = 0; P < np; ++P) {
            const Pass d = pass_desc(P, jq, h);
            ATT_FLUSH();
            if (d.first) { qf[0] = qn[0]; qf[1] = qn[1]; lsum = 0.f;
#pragma unroll
                for (int dt = 0; dt < 4; ++dt) O[dt] = (f32x4){0.f, 0.f, 0.f, 0.f}; }
            const bool more = P + 1 < np;
            if (more) { const Pass dn = pass_desc(P + 1, jq, h); stage_dma(lds, dn, (P + 1) & 1, Kb, Vb, zrow, rowbase, w, lane);
                if (dn.first) { const bf16_t* qp = Qb + (rowbase + task_qtok(dn, jq, w, fr)) * QW + dn.hc + 8 * fq; qn[0] = *(const bf16x8*)qp; qn[1] = *(const bf16x8*)(qp + 32); } }
            const int sl = P; const bool has_sl = sl < n_sl; f32x4 kv[2][4];
            const int shi = hi0 + (sl >> 2), sit = shi >> 1, shalf = shi & 1, sb = sit / 3, sg = sit - 3 * sb;
            if (has_sl) { const int dil = sg == 0 ? 1 : (sg == 1 ? 4 : 16), nbuf = sg == 0 ? 128 : (sg == 1 ? 512 : 2048);
                const float* cache = (sg == 0 ? c0p : (sg == 1 ? c1p : c2p)) + (size_t)sb * nbuf * 1024;
                if ((sl & 3) == 0) {
#pragma unroll
                    for (int jj = 0; jj < 2; ++jj) sq[jj] = *(const f32x4*)(qs + (size_t)sb * QW + sg * 512 + 256 * jj + 4 * lane); }
#pragma unroll
                for (int r = 0; r < 2; ++r) { const f32x4* rowp = (const f32x4*)(cache + (size_t)(64 * shalf + 16 * (sl & 3) + 2 * w + r) * dil * 1024) + lane;
#pragma unroll
                    for (int c = 0; c < 4; ++c) kv[r][c] = __builtin_nontemporal_load(rowp + 64 * c); } }
            { LAS const unsigned char* kb = lds + k_off(P & 1); LAS const unsigned char* vb = lds + v_off(P & 1);
                const int qtok = task_qtok(d, jq, w, fr); const size_t tq = rowbase + qtok;
                if (d.g < 2) {
                    const int kmin = d.krvalid0 - 16 * w; const int c_lo = kmin >= 32 ? (kmin >> 5) : 0;
                    wave_task(kb, vb, qf, 16 * w, c_lo, 5, 0, 128, kmin, m0, O, lsum, lane);
                    lsum += shfl_xor_f(lsum, 16); lsum += shfl_xor_f(lsum, 32);
#pragma unroll
                    for (int dt = 0; dt < 4; ++dt) Opend[dt] = O[dt];
                    lpend = lsum; ppend = (size_t)d.g * MTOK + tq; pend = true;
                    if (P == 7) ATT_FLUSH();
                } else {
                    const int hi = 32 * jq + 16 * (w & 1) - 64 * d.s;
                    int c_hi = hi + 15 < 0 ? 0 : ((hi + 15) >> 5) + 1; if (c_hi > 2) c_hi = 2;
                    wave_task(kb, vb, qf, 64 * (w >> 1), 0, c_hi, -100000, hi, -100000, m0, O, lsum, lane);
                    if (d.last) {
                        lsum += shfl_xor_f(lsum, 16); lsum += shfl_xor_f(lsum, 32);
                        const float l = lsum + lpart[tq * 8 + h] + lpart[((size_t)MTOK + tq) * 8 + h]; const float inv = 1.0f / l;
                        const bf16_t* op0 = opart + tq * OW + h * 64 + 4 * fq; const bf16_t* op1 = op0 + (size_t)MTOK * OW; bf16_t* od = Ob + tq * OW + h * 64 + 4 * fq;
#pragma unroll
                        for (int dt = 0; dt < 4; ++dt) { const u32x2 a0 = *(const u32x2*)(op0 + 16 * dt), a1 = *(const u32x2*)(op1 + 16 * dt);
                            const f32x4 p0 = {__builtin_bit_cast(float, a0.x << 16), __builtin_bit_cast(float, a0.x & 0xffff0000u), __builtin_bit_cast(float, a0.y << 16), __builtin_bit_cast(float, a0.y & 0xffff0000u)};
                            const f32x4 p1 = {__builtin_bit_cast(float, a1.x << 16), __builtin_bit_cast(float, a1.x & 0xffff0000u), __builtin_bit_cast(float, a1.y << 16), __builtin_bit_cast(float, a1.y & 0xffff0000u)};
                            const f32x4 o = (O[dt] + p0 + p1) * inv;
                            u32x2 pw; pw.x = cvt_pk_bf16(o[0], o[1]); pw.y = cvt_pk_bf16(o[2], o[3]); *(u32x2*)(od + 16 * dt) = pw; }
                    }
                }
            }
            if (has_sl) {
#pragma unroll
                for (int r = 0; r < 2; ++r)
#pragma unroll
                    for (int jj = 0; jj < 2; ++jj) { const f32x4 k = kv[r][jj]; float s = (k[0] * sq[jj][0] + k[1] * sq[jj][1]) + (k[2] * sq[jj][2] + k[3] * sq[jj][3]);
                        s = rowred<16>(s); const float p = __builtin_amdgcn_exp2f(s - m0); sl_[jj] += p; so[jj] += kv[r][2 + jj] * p; }
                if ((sl & 3) == 3) {
                    if (w == 0 && shalf == 1) {
#pragma unroll
                        for (int jj = 0; jj < 2; ++jj) { const f32x4 k = *(const f32x4*)(kn + (size_t)sb * QW + sg * 512 + 256 * jj + 4 * lane), v = *(const f32x4*)(vn + (size_t)sb * QW + sg * 512 + 256 * jj + 4 * lane);
                            float s = (k[0] * sq[jj][0] + k[1] * sq[jj][1]) + (k[2] * sq[jj][2] + k[3] * sq[jj][3]); s = rowred<16>(s); const float p = __builtin_amdgcn_exp2f(s - m0); sl_[jj] += p; so[jj] += v * p; } }
#pragma unroll
                    for (int jj = 0; jj < 2; ++jj) { *(LAS f32x4*)(sred + w * 576 + 256 * jj + 4 * lane) = so[jj]; if ((lane & 15) == 0) sred[w * 576 + 512 + 4 * jj + (lane >> 4)] = sl_[jj];
                        so[jj] = (f32x4){0.f, 0.f, 0.f, 0.f}; sl_[jj] = 0.f; }
                }
            }
            __syncthreads();
            if (has_sl && (sl & 3) == 3) {
                for (int e = F.tid; e < 520; e += 512) { float s = 0.f;
#pragma unroll
                    for (int w8 = 0; w8 < 8; ++w8) s += sred[w8 * 576 + e];
                    if (e < 512) sop[((size_t)(2 * sg + shalf) * NSMP + sb) * OW + e] = s; else slp[((size_t)(2 * sg + shalf) * NSMP + sb) * 8 + (e - 512)] = s; }
            }
        }
    }
    __syncthreads();
}
}

#ifndef RIDE_QKV
#define RIDE_QKV 1
#endif
struct Args { const float* in[N_IN]; float* out; unsigned char* ws; };
__global__ void __launch_bounds__(NWAVES * 64, 2) yoco_fwd(Args args) {
    extern __shared__ __attribute__((aligned(16))) unsigned char lds_raw[];
    Frame F;
    F.lds = (LAS unsigned char*)lds_raw;
    F.MISC = (volatile LAS unsigned*)(F.lds + MISC_OFF);
    F.tid = threadIdx.x; F.lane = F.tid & 63; F.wave = __builtin_amdgcn_readfirstlane(F.tid >> 6);
    F.G = gridDim.x; F.bx = blockIdx.x; F.vcu = (F.G % 8 == 0) ? (F.bx % 8) * (F.G / 8) + F.bx / 8 : F.bx;
    for (int u = F.tid; u < (LDS_BYTES - LDSCTL_OFF) / 4; u += NWAVES * 64) ((LAS unsigned*)(F.lds + LDSCTL_OFF))[u] = 0u;
    __syncthreads();
    if (F.tid == 0) { volatile LAS unsigned long long* tab = (volatile LAS unsigned long long*)(F.lds + PTAB_OFF);
#pragma unroll
        for (int i = 0; i < N_IN; ++i) tab[i] = (unsigned long long)args.in[i];
        tab[N_IN] = (unsigned long long)args.out; tab[N_IN + 1] = (unsigned long long)args.ws; }
    __syncthreads();
    F.out = ptab_out(F); F.ws = ptab_ws(F); F.ctl = (gu32*)(F.ws + WS_CTL); F.ctlf = (float*)(F.ws + WS_CTL);
    const int wave0 = F.wave;
    XcdBarrier bar = xcd_barrier_post((unsigned*)(F.ctl + CW_BAR), F.MISC + 8);
#define GRID_BAR() do { XcdBarrier b_ = bar; long z_ = 0; asm volatile("" : "+s"(z_), "+s"(b_.x)); b_.bar = bar.bar + z_; xcd_barrier(b_); } while (0)

#define PHASE_BEGIN() do { int w_ = wave0; asm volatile("" : "+s"(w_)); int t_; asm volatile("v_mbcnt_lo_u32_b32 %0, -1, 0\n\tv_mbcnt_hi_u32_b32 %0, -1, %0" : "=v"(t_)); t_ += w_ * 64; F.tid = t_; F.lane = t_ & 63; F.wave = __builtin_amdgcn_readfirstlane(t_ >> 6); \
        { int g_ = gridDim.x, b_ = blockIdx.x; asm volatile("" : "+s"(g_), "+s"(b_)); F.G = g_; F.bx = b_; F.vcu = (g_ % 8 == 0) ? (b_ % 8) * (g_ / 8) + b_ / 8 : b_; } \
        F.out = ptab_out(F); F.ws = ptab_ws(F); F.ctl = (gu32*)(F.ws + WS_CTL); F.ctlf = (float*)(F.ws + WS_CTL); } while (0)
#define WSP (F.ws)
#define YP (F.out + O_YP)
#define XBP ((bf16_t*)(F.ws + WS_XB) + XB_PAD_ROWS * DM)
#define XSP ((float*)(F.ws + WS_SMP + SM_XS))
#define YSP (F.out + O_YS)

    PHASE_BEGIN();
    p0_weights(F);
    __syncthreads();
    pool_d_phase<true, false>(F, inp(F, IN_XP), nullptr, inp(F, IN_GPOOL), (bf16_t*)(WSP + WS_DBUF), F.out + O_POOLP);
    smp_pool_d(F, 0, inp(F, IN_XS), true, nullptr);
    GRID_BAR();

    for (int layer = 0; layer < 4; ++layer) {
        pg8::Gemm gm; const float* mix_xin; const float* smp_xin;
        if (layer < 2) {
            if (layer == 1) {
                PHASE_BEGIN();
                pool_d_phase<false, true>(F, XBP, ssp(F, 1), inp(F, IN_GPOOL) + DM, (bf16_t*)(WSP + WS_DBUF), F.out + O_POOLP + (size_t)NBATCH * PHIST * DM);
                smp_pool_d(F, 1, XSP, false, sss(F, 1));
                GRID_BAR();
            }
            gm = pg8::Gemm{(const bf16_t*)(WSP + WS_DBUF), (const bf16_t*)(WSP + WS_WP) + (size_t)layer * 4 * 65536, 256, DM, (long)256 * DM * 2, (long)128 * DM * 2, (long)256 * 2};
            mix_xin = layer == 0 ? inp(F, IN_XP) : nullptr; smp_xin = layer == 0 ? inp(F, IN_XS) : XSP;
        } else {
            const int j = layer - 2;
            {
                PHASE_BEGIN();
                const int nN = layer == 2 ? 18 : 6;
                const pg8::Gemm g{XBP, layer == 2 ? (const bf16_t*)(WSP + WS_WKVQ) : (const bf16_t*)(WSP + WS_WQ3), DM, DM, (long)256 * DM * 2, (long)128 * DM * 2, 0};
                { LAS float* rd = (LAS float*)(F.lds + LDSCTL_OFF + 512); if (F.tid < 128) { const int e = F.tid >> 4; rd[F.tid] = ((const float*)(WSP + WS_ROT))[(128 * (e >> 2) + 16 * (e & 3)) * 16 + (F.tid & 15)]; } __syncthreads(); }
                pg8::StaticOrder S; S.init(MTOK / 256 + RIDE_QKV, nN, F.G, F.bx, RIDE_QKV);
                const pg8::EpiQKV E{ssp(F, 2 * layer - 1), (const float*)(WSP + WS_ROT), WSP, F.out, inp(F, IN_KGAIN), (long)((const char*)(inp(F, IN_QGAIN) + j * HD) - (const char*)inp(F, IN_KGAIN)), 0.125f * LOG2E, layer == 2 ? 12 : 0, (const LAS float*)(F.lds + LDSCTL_OFF + 512)};
                pg8::gemm_phase<pg8::EpiQKV, pg8::StaticOrder, 0>(F.lds + RING_OFF, g, S, E, F.tid);
            }
#if !RIDE_QKV
                PHASE_BEGIN();
                smp_qkv(F, layer, sss(F, 2 * layer - 1));
#endif
                { PHASE_BEGIN(); const int nN2 = layer == 2 ? 18 : 6;
                    convert_weights(F, layer == 2 ? WSEG2B : WSEG3B, layer == 2 ? WSEG3B : WSEG4, ((MTOK / 256 + RIDE_QKV) * nN2) % F.G); }
            GRID_BAR();
            PHASE_BEGIN();
            att::phase(F, j);
            GRID_BAR();
            gm = pg8::Gemm{(const bf16_t*)(WSP + WS_OB), (const bf16_t*)(WSP + WS_WO) + (size_t)j * DM * OW, OW, OW, (long)256 * OW * 2, (long)128 * OW * 2, 0};
            mix_xin = nullptr; smp_xin = XSP;
        }
        {
            if (layer >= 2) { PHASE_BEGIN(); smp_attn_finalize(F, layer); }
            PHASE_BEGIN();
            pg8::StaticOrder S; S.init(MTOK / 256, 4, F.G, F.bx);
            const pg8::EpiResid E{mix_xin, nullptr, XBP, ssp(F, 2 * layer)};
            pg8::gemm_phase<pg8::EpiResid, pg8::StaticOrder, 0>(F.lds + RING_OFF, gm, S, E, F.tid);
            PHASE_BEGIN();
            smp_mixer_gemm(F, layer, smp_xin, XSP, sss(F, 2 * layer));
        }
        GRID_BAR();
        {
            PHASE_BEGIN();
            const pg8::Gemm g{XBP - 2 * DM, (const bf16_t*)(WSP + WS_WUP) + (size_t)layer * DUP * DM, DM, DM, (long)252 * DM * 2, (long)4 * DM * 2, 0};
            pg8::UpOrder S; S.init(F.G, F.bx);
            const pg8::EpiUp E{(bf16_t*)(WSP + WS_ACT), ssp(F, 2 * layer), inp(F, IN_CONVW) + (size_t)layer * 3 * DUP, inp(F, IN_CONVB) + (size_t)layer * DUP, F.out + O_CONVP + (size_t)layer * NBATCH * 2 * DUP, (LAS float*)(F.lds + LDSCTL_OFF + 1024), layer};
            pg8::gemm_phase<pg8::EpiUp, pg8::UpOrder, 1>(F.lds + RING_OFF, g, S, E, F.tid);
            if (layer == 0) {
                const int lo = (66 * 22) % F.G, rd = lo + 22 <= F.G ? 22 : 0;
                PHASE_BEGIN(); convert_weights(F, WSEG1, WSEG1 + F.G, 0);
                PHASE_BEGIN(); convert_weights(F, WSEG1 + F.G, WSEG1 + F.G + 2 * rd, lo, lo + rd);
                PHASE_BEGIN(); convert_weights(F, WSEG1 + F.G + 2 * rd, WSEG2, lo + rd < F.G ? lo + rd : 0); }
            if (layer == 1) { const int lo = (66 * 22) % F.G, rd = lo + 22 <= F.G ? 22 : 0; PHASE_BEGIN(); convert_weights(F, WSEG2, WSEG2B, lo + rd < F.G ? lo + rd : 0); }
        }
        GRID_BAR();
        {
            PHASE_BEGIN();
            const pg8::Gemm g{(const bf16_t*)(WSP + WS_ACT), (const bf16_t*)(WSP + WS_WDOWN) + (size_t)layer * DM * DFF, DFF, DFF, (long)256 * DFF * 2, (long)128 * DFF * 2, 0};
            pg8::StaticOrder S; S.init(MTOK / 256, 4, F.G, F.bx);
            const pg8::EpiResid E{nullptr, layer == 3 ? YP : nullptr, XBP, layer < 3 ? ssp(F, 2 * layer + 1) : nullptr};
            pg8::gemm_phase<pg8::EpiResid, pg8::StaticOrder, 0>(F.lds + RING_OFF, g, S, E, F.tid);
            PHASE_BEGIN();
            smp_down(F, layer, XSP, layer < 3 ? XSP : YSP, layer < 3 ? sss(F, 2 * layer + 1) : nullptr);
        }
        if (layer < 3) GRID_BAR();
    }
    if (blockIdx.x == 0 && F.tid == 0 && __hip_atomic_load((unsigned*)(F.ctl + CW_BAR) + XB_TMO, RLX_AGENT) != 0u) F.out[O_YS] = __builtin_nanf("");
#undef GRID_BAR
#undef PHASE_BEGIN
#undef WSP
#undef YP
#undef XBP
#undef XSP
#undef YSP
}

extern "C" void kernel_launch(void* const* d_in, const int* in_sizes, int n_in, void* d_out, int out_size, void* d_ws, size_t ws_size, hipStream_t stream) {
    static int grid = 0;
    if (grid == 0) {
        if (n_in != N_IN || in_sizes[0] != MTOK * DM || (size_t)out_size != O_END || ws_size < WS_END) { fprintf(stderr, "kernel_launch: unexpected shapes (n_in %d, in0 %d, out %d, ws %zu); nothing launched\n", n_in, n_in > 0 ? in_sizes[0] : -1, out_size, ws_size); grid = -1; return; }
        int dev = 0, cus = 0, per_cu = 0;
        if (hipGetDevice(&dev) != hipSuccess || hipDeviceGetAttribute(&cus, hipDeviceAttributeMultiprocessorCount, dev) != hipSuccess) { grid = -1; return; }
        if (hipFuncSetAttribute((const void*)yoco_fwd, hipFuncAttributeMaxDynamicSharedMemorySize, LDS_BYTES) != hipSuccess) { fprintf(stderr, "kernel_launch: hipFuncSetAttribute failed\n"); grid = -1; return; }
        if (hipOccupancyMaxActiveBlocksPerMultiprocessor(&per_cu, (const void*)yoco_fwd, NWAVES * 64, LDS_BYTES) != hipSuccess || per_cu < 1)
            fprintf(stderr, "kernel_launch: note: occupancy query reports %d workgroups per CU\n", per_cu);
        (void)hipGetLastError();
        grid = cus;
    }
    if (grid < 0) return;
    if (hipMemsetAsync((char*)d_ws + WS_CTL, 0, CTL_ZERO_BYTES, stream) != hipSuccess) { fprintf(stderr, "kernel_launch: hipMemsetAsync failed\n"); return; }
    Args a{};
    for (int i = 0; i < N_IN; ++i) a.in[i] = (const float*)d_in[i];
    a.out = (float*)d_out; a.ws = (unsigned char*)d_ws;
    hipLaunchKernelGGL(yoco_fwd, dim3(grid), dim3(NWAVES * 64), LDS_BYTES, stream, a);
    const hipError_t le = hipPeekAtLastError();
    if (le != hipSuccess) fprintf(stderr, "kernel_launch: launch failed: %s (grid %d)\n", hipGetErrorName(le), grid);
}
```

```cpp
#include <hip/hip_runtime.h>
#include <cstdio>
#include <cstdint>

#define LAS __attribute__((address_space(3)))
#define GAS __attribute__((address_space(1)))
typedef unsigned short bf16_t;
typedef short bf16x8 __attribute__((ext_vector_type(8)));
typedef short s16x4 __attribute__((ext_vector_type(4)));
typedef float f32x4 __attribute__((ext_vector_type(4)));
typedef float f32x2 __attribute__((ext_vector_type(2)));
typedef unsigned u32x4 __attribute__((ext_vector_type(4)));
typedef unsigned u32x2 __attribute__((ext_vector_type(2)));
typedef GAS unsigned gu32;

constexpr int DM = 1024, NBATCH = 8, SEQ = 2048, MTOK = NBATCH * SEQ, NSMP = 128, DFF = 2816, DUP = 2 * DFF;
constexpr int NHEAD = 8, HD = 64, NGRP = 3, QW = NGRP * NHEAD * HD  , OW = NHEAD * HD  , KVW = 2 * QW  ;
constexpr int PHIST = 15;
constexpr int SMP_ROW0 = 252 * 65 + 126 - 2;
constexpr float NORM_EPS = 1e-6f;
constexpr float LOG2E = 1.4426950408889634f;

enum { IN_XP = 0, IN_XS, IN_SPOOL, IN_SCONV, IN_C128, IN_C512, IN_C2048, IN_GPOOL, IN_WPOOL, IN_PSCALE, IN_GFFN, IN_WUP, IN_CONVW, IN_CONVB, IN_WDOWN,
       IN_GKV, IN_WKV, IN_KGAIN, IN_GATTN, IN_WQ, IN_QGAIN, IN_WO, N_IN };
constexpr size_t O_YP = 0, O_YS = O_YP + (size_t)MTOK * DM, O_POOLP = O_YS + (size_t)NSMP * DM, O_POOLS = O_POOLP + (size_t)2 * NBATCH * PHIST * DM,
                 O_CONVP = O_POOLS + (size_t)2 * NSMP * PHIST * DM, O_CONVS = O_CONVP + (size_t)4 * NBATCH * 2 * DUP, O_KV128P = O_CONVS + (size_t)4 * NSMP * 2 * DUP,
                 O_KV128S = O_KV128P + (size_t)NBATCH * 128 * 1024, O_KV512P = O_KV128S + (size_t)NSMP * 1024, O_KV512S = O_KV512P + (size_t)NBATCH * 512 * 1024,
                 O_KV2048P = O_KV512S + (size_t)NSMP * 1024, O_KV2048S = O_KV2048P + (size_t)NBATCH * 2048 * 1024, O_END = O_KV2048S + (size_t)NSMP * 1024;
static_assert(O_END == 49627136, "output size");

constexpr size_t MiB = 1u << 20;
constexpr size_t WS_CTL = 0, CTL_ZERO_BYTES = 512 * 1024;
constexpr size_t WS_ROT = 2 * MiB;
constexpr size_t WS_SMP = 482 * MiB;
constexpr size_t WS_WP = 8 * MiB;
constexpr size_t WS_WO = 10 * MiB;
constexpr size_t WS_WKVQ = 12 * MiB;
constexpr size_t WS_WQ3 = 22 * MiB;
constexpr size_t WS_WDOWN = 26 * MiB;
constexpr size_t WS_WUP = 50 * MiB;
constexpr size_t WS_XB = 98 * MiB;
constexpr size_t XB_PAD_ROWS = 256, XB_TAIL_ROWS = 512;
constexpr size_t WS_DBUF = 132 * MiB;
constexpr size_t WS_ACT = 164 * MiB;
constexpr size_t WS_QB = 256 * MiB, WS_KB = 304 * MiB, WS_VB = 352 * MiB;
constexpr size_t WS_OB = 400 * MiB;
constexpr size_t WS_OPART = 416 * MiB;
constexpr size_t WS_LPART = 480 * MiB;
constexpr size_t WS_END = 490 * MiB;
static_assert(WS_XB + (XB_PAD_ROWS + MTOK + XB_TAIL_ROWS) * 2048 <= WS_DBUF && WS_ACT + (size_t)MTOK * DFF * 2 <= WS_QB, "ws map");

constexpr int CW_TMO = 0, CW_CODE = 1;
constexpr int CW_BAR = 4096;
constexpr int SS_STRIDE = MTOK + 512, SS_FRONT = 64;
constexpr int CW_SSP = 8192;
constexpr int CW_SSS = CW_SSP + 7 * SS_STRIDE + 64;
constexpr int CW_SUB = CW_SSS + 8 * 128;
constexpr int CW_END = CW_SUB + 64;
static_assert((size_t)CW_END * 4 <= CTL_ZERO_BYTES, "CTL words inside the memset region");

constexpr size_t SM_XS = 0;
constexpr size_t SM_XSB = SM_XS + 128 * 1024 * 4;
constexpr size_t SM_DS = SM_XSB + 128 * 1024 * 2;
constexpr size_t SM_ACT = SM_DS + 128 * 1024 * 2;
constexpr size_t SM_Q = SM_ACT + 128 * 2816 * 2;
constexpr size_t SM_KN = SM_Q + 128 * 1536 * 4;
constexpr size_t SM_VN = SM_KN + 128 * 1536 * 4;
constexpr size_t SM_OP = SM_VN + 128 * 1536 * 4;
constexpr size_t SM_LP = SM_OP + 6 * 128 * 512 * 4;
constexpr size_t SM_OA = SM_LP + 6 * 128 * 8 * 4;
constexpr size_t SM_END = SM_OA + 128 * 512 * 2;
static_assert(SM_END <= 8 * MiB, "sample buffers");

constexpr int RING_OFF = 0, RING_BYTES = 131072;
constexpr int LDSCTL_OFF = RING_BYTES, MISC_OFF = LDSCTL_OFF + 320;
constexpr int LDS_BYTES = 163840;
constexpr int NWAVES = 8;

#define RLX_AGENT __ATOMIC_RELAXED, __HIP_MEMORY_SCOPE_AGENT
#define LDS_WAIT() asm volatile("s_waitcnt lgkmcnt(0)" ::: "memory")
#define VM_WAIT() asm volatile("s_waitcnt vmcnt(0)" ::: "memory")

__device__ __forceinline__ unsigned f2bf(float f) { unsigned u = __builtin_bit_cast(unsigned, f); return (u + 0x7fffu + ((u >> 16) & 1u)) >> 16; }
__device__ __forceinline__ unsigned pk2(float lo, float hi) { return f2bf(lo) | (f2bf(hi) << 16); }
typedef __bf16 bf16x2_t __attribute__((ext_vector_type(2)));
__device__ __forceinline__ unsigned cvt_pk_bf16(float lo, float hi) { const f32x2 v = {lo, hi}; return __builtin_bit_cast(unsigned, __builtin_convertvector(v, bf16x2_t)); }
__device__ __forceinline__ float bf2f(unsigned short b) { return __builtin_bit_cast(float, (unsigned)b << 16); }
__device__ __forceinline__ float shfl_xor_f(float v, int o) { int t; asm volatile("v_mbcnt_lo_u32_b32 %0, -1, 0\n\tv_mbcnt_hi_u32_b32 %0, -1, %0" : "=v"(t));
    return __builtin_bit_cast(float, __builtin_amdgcn_ds_bpermute((t ^ o) << 2, __builtin_bit_cast(int, v))); }
__device__ __forceinline__ float wave_sum(float v) {
#pragma unroll
    for (int o = 1; o < 64; o <<= 1) v += shfl_xor_f(v, o);
    return v;
}
__device__ __forceinline__ float dpp_shr1(float x) { return __builtin_bit_cast(float, __builtin_amdgcn_update_dpp(0, __builtin_bit_cast(int, x), 0x111, 0xf, 0xf, true)); }
__device__ __forceinline__ f32x4 dpp_shr1(f32x4 v) { return (f32x4){dpp_shr1(v[0]), dpp_shr1(v[1]), dpp_shr1(v[2]), dpp_shr1(v[3])}; }

namespace pg8 {
constexpr int BM = 256, BK = 64, HALF = 128, HTB = HALF * BK * 2  , STAGE_BYTES = 8 * HTB, NXCD = 8, WGM = 8;

__host__ __device__ __forceinline__ int lds_byte(int r, int c) { const int st = (r >> 4) * 2 + (c >> 5), rr = r & 15, cc = c & 31, ob = rr * 64 + cc * 2; return st * 1024 + (ob ^ (((ob >> 9) & 1) << 5)); }
__host__ __device__ __forceinline__ void stage_rc(int b, int& R, int& C) { const int st = b / 1024, sb = b % 1024, swz = sb ^ (((sb >> 9) & 1) << 5); R = (st >> 1) * 16 + swz / 64; C = (st & 1) * 32 + (swz % 64) / 2; }
__host__ __device__ __forceinline__ int perm32(int rho) { const int n = rho >> 4, i = rho & 15; return 8 * (i >> 2) + 4 * n + (i & 3); }

struct Unit { int pm, pn; };
struct Gemm { const bf16_t* A; const bf16_t* Bt; int K; int lda; long tstepA; long hstepA; long pnstepA; };

struct StaticOrder {
    int nM, nN, nwg, G, c, rev;
    __host__ __device__ void init(int nM_, int nN_, int G_, int c_, int rev_ = 0) { nM = nM_; nN = nN_; nwg = nM * nN; G = G_; c = c_; rev = rev_; }
    __host__ __device__ bool next(int i, Unit& u) const {
        const long L = (long)i * G + c; if (L >= nwg) return false;
        int wgid = rev ? nwg - 1 - (int)L : (int)L; { const int q = nwg / NXCD, r = nwg % NXCD, xcd = wgid % NXCD, off = wgid / NXCD; wgid = (xcd < r ? xcd * (q + 1) : r * (q + 1) + (xcd - r) * q) + off; }
        const int nig = WGM * nN, gid = wgid / nig, fm = gid * WGM, gsz = (nM - fm) < WGM ? (nM - fm) : WGM;
        u.pm = fm + ((wgid % nig) % gsz); u.pn = (wgid % nig) / gsz; return true;
    }
    __device__ __forceinline__ void a_ready(const Unit&) const {}
    __device__ __forceinline__ void done(const Unit&) const {}
};

struct UpOrder {
    int G, c, sp0;
    __host__ __device__ void init(int G_, int c_) { G = G_; c = c_; const int lo = (66 * 22) % G_; sp0 = (lo + 22 <= G_) ? lo : 65 * 22; }
    __host__ __device__ bool next(int i, Unit& u) const {
        const long L = (long)i * G + c; if (L >= 66 * 22) return false;
        if (L >= sp0 && L < sp0 + 22) { u.pm = 65; u.pn = (int)L - sp0; return true; }
        constexpr int nM = 65, nN = 22, nwg = nM * nN;
        int wgid; { const int r = (int)(L % NXCD), s1 = sp0 + 22, Lc = (int)L < sp0 ? sp0 : ((int)L < s1 ? (int)L : s1);
#define UPO_CNT(x, rr) (((x) + NXCD - 1 - (rr)) / NXCD)
            int off = UPO_CNT((int)L, r) - (UPO_CNT(Lc, r) - UPO_CNT(sp0, r)), base = 0;
            for (int q = 0; q < r; ++q) base += UPO_CNT(66 * 22, q) - (UPO_CNT(s1, q) - UPO_CNT(sp0, q));
#undef UPO_CNT
            wgid = base + off; }
        const int nig = WGM * nN, gid = wgid / nig, fm = gid * WGM, gsz = (nM - fm) < WGM ? (nM - fm) : WGM;
        u.pm = fm + ((wgid % nig) % gsz); u.pn = (wgid % nig) / gsz; return true;
    }
    __device__ __forceinline__ void a_ready(const Unit&) const {}
    __device__ __forceinline__ void done(const Unit&) const {}
};

template <int AMAP> __host__ __device__ __forceinline__ int a_rowmap(int R) { return AMAP == 0 ? R : 126 * (R >> 6) + 8 * (R & 15) + ((R >> 4) & 3); }

template <class Epi, class Sched, int AMAP, bool ALIGN_EPI = true, bool SP2 = true>
__device__ __forceinline__ void gemm_phase(LAS unsigned char* lds, const Gemm g, const Sched& S, const Epi& E, const int tid) {
    const int wid = __builtin_amdgcn_readfirstlane(tid >> 6), lane = tid & 63, wr = wid >> 2, wc = wid & 3, fr = lane & 15, fq = lane >> 4;
    const int K = g.K, nt = K / BK;
    unsigned voffA[2], voffB[2];
#pragma unroll
    for (int i = 0; i < 2; ++i) { int R, C; stage_rc(tid * 16 + i * 8192, R, C); const int Rb = Epi::PERM ? ((R & ~31) + perm32(R & 31)) : R;
        voffA[i] = (unsigned)(a_rowmap<AMAP>(R) * g.lda + C) * 2u; voffB[i] = (unsigned)(Rb * K + C) * 2u; }
    const size_t kstep = (size_t)(BK * 2);
    const size_t hA = (size_t)g.hstepA;
    const size_t hB = (size_t)HALF * K * 2;
    const size_t tB = 2 * hB;
    const unsigned ldsw = (unsigned)wid * 1024u;
    const int aoff = lds_byte(wr * 64 + fr, fq * 8), boff = lds_byte(wc * 32 + fr, fq * 8);
#define PG8_SA(b, h) (((b) * 2 + (h)) * HTB)
#define PG8_SB(b, h) ((4 + (b) * 2 + (h)) * HTB)
#define PG8_STAGE(bufoff, gbase, voff) do { _Pragma("unroll") for (int _i = 0; _i < 2; ++_i) \
        __builtin_amdgcn_global_load_lds((const unsigned*)((const char*)(gbase) + (voff)[_i]), (LAS unsigned*)(lds + (bufoff) + ldsw + _i * 8192), 16, 0, 0); } while (0)
#define PG8_LDA(dst, b, h) do { _Pragma("unroll") for (int m = 0; m < 4; ++m) _Pragma("unroll") for (int k = 0; k < 2; ++k) dst[m][k] = *(const LAS bf16x8*)(lds + PG8_SA(b, h) + aoff + m * 2048 + k * 1024); } while (0)
#define PG8_LDB(dst, b, h) do { _Pragma("unroll") for (int n = 0; n < 2; ++n) _Pragma("unroll") for (int k = 0; k < 2; ++k) dst[n][k] = *(const LAS bf16x8*)(lds + PG8_SB(b, h) + boff + n * 2048 + k * 1024); } while (0)
#define PG8_MMA(ai, bj, At, Bt) do { __builtin_amdgcn_s_setprio(1); _Pragma("unroll") for (int m = 0; m < 4; ++m) _Pragma("unroll") for (int n = 0; n < 2; ++n) _Pragma("unroll") for (int k = 0; k < 2; ++k) \
        acc[ai][bj][m][n] = __builtin_amdgcn_mfma_f32_16x16x32_bf16(Bt[n][k], At[m][k], acc[ai][bj][m][n], 0, 0, 0); __builtin_amdgcn_s_setprio(0); } while (0)
#define PG8_WAIT_V(n) asm volatile("s_waitcnt vmcnt(" #n ")" ::: "memory")
#define PG8_WAIT_L(n) asm volatile("s_waitcnt lgkmcnt(" #n ")" ::: "memory")
#define PG8_BAR __builtin_amdgcn_s_barrier()
#define PG8_SCHED __builtin_amdgcn_sched_barrier(0)
    Unit cur, nxt; int ui = 0;
    if (!S.next(0, cur)) return;
    f32x4 acc[2][2][4][2];
#pragma unroll
    for (int a = 0; a < 2; ++a)
#pragma unroll
        for (int b = 0; b < 2; ++b)
#pragma unroll
            for (int m = 0; m < 4; ++m)
#pragma unroll
                for (int n = 0; n < 2; ++n) acc[a][b][m][n] = (f32x4){0.f, 0.f, 0.f, 0.f};
    bf16x8 At[4][2], B0[2][2], B1[2][2];
    const char* cA = (const char*)g.A + (long)cur.pm * g.tstepA + (long)cur.pn * g.pnstepA; const char* cB = (const char*)g.Bt + (size_t)cur.pn * tB;
    S.a_ready(cur);
    E.prime(cur, tid);
    if constexpr (SP2) {
        PG8_STAGE(PG8_SB(0, 0), cB, voffB); PG8_STAGE(PG8_SB(0, 1), cB + hB, voffB); PG8_STAGE(PG8_SA(0, 0), cA, voffA); PG8_STAGE(PG8_SA(0, 1), cA + hA, voffA);
        if (wr == 1) PG8_BAR;
        PG8_WAIT_V(2); PG8_BAR;
        PG8_STAGE(PG8_SB(1, 0), cB + kstep, voffB); PG8_STAGE(PG8_SA(1, 0), cA + kstep, voffA); PG8_STAGE(PG8_SB(1, 1), cB + hB + kstep, voffB);
        PG8_WAIT_V(6); PG8_BAR;
    } else {
        PG8_STAGE(PG8_SB(0, 0), cB, voffB); PG8_STAGE(PG8_SA(0, 0), cA, voffA); PG8_STAGE(PG8_SB(0, 1), cB + hB, voffB); PG8_STAGE(PG8_SA(0, 1), cA + hA, voffA);
        if (wr == 1) PG8_BAR;
        PG8_WAIT_V(4); PG8_BAR;
        PG8_STAGE(PG8_SB(1, 0), cB + kstep, voffB); PG8_STAGE(PG8_SA(1, 0), cA + kstep, voffA); PG8_STAGE(PG8_SB(1, 1), cB + hB + kstep, voffB);
        PG8_WAIT_V(6); PG8_BAR;
    }
    for (;;) {
        const bool has_next = S.next(ui + 1, nxt);
        const char* nA = has_next ? (const char*)g.A + (long)nxt.pm * g.tstepA + (long)nxt.pn * g.pnstepA : cA; const char* nB = has_next ? (const char*)g.Bt + (size_t)nxt.pn * tB : cB;
        for (int t = 0; t < nt; t += 2) {
            const bool last = (t == nt - 2);
            const char* a1 = cA + (size_t)(t + 1) * kstep;
            const char* a2 = last ? nA : cA + (size_t)(t + 2) * kstep; const char* b2 = last ? nB : cB + (size_t)(t + 2) * kstep;
            const char* a3 = a2 + kstep; const char* b3 = b2 + kstep;
            if (last && has_next) S.a_ready(nxt);
            if constexpr (SP2) {
            PG8_LDB(B0, 0, 0); PG8_LDB(B1, 0, 1); PG8_SCHED; PG8_LDA(At, 0, 0); PG8_STAGE(PG8_SA(1, 1), a1 + hA, voffA);
            PG8_WAIT_V(8); PG8_WAIT_L(0); PG8_BAR; PG8_MMA(0, 0, At, B0); PG8_MMA(0, 1, At, B1); PG8_BAR; PG8_SCHED;
            PG8_LDA(At, 0, 1); PG8_STAGE(PG8_SB(0, 0), b2, voffB); PG8_STAGE(PG8_SB(0, 1), b2 + hB, voffB); PG8_STAGE(PG8_SA(0, 0), a2, voffA);
            PG8_WAIT_V(8); PG8_WAIT_L(0); PG8_BAR; PG8_MMA(1, 0, At, B0); PG8_MMA(1, 1, At, B1); PG8_BAR; PG8_SCHED;
            PG8_LDB(B0, 1, 0); PG8_LDB(B1, 1, 1); PG8_SCHED; PG8_LDA(At, 1, 0); PG8_STAGE(PG8_SA(0, 1), a2 + hA, voffA);
            PG8_WAIT_V(8); PG8_WAIT_L(0); PG8_BAR; PG8_MMA(0, 0, At, B0); PG8_MMA(0, 1, At, B1); PG8_BAR; PG8_SCHED;
            PG8_LDA(At, 1, 1); PG8_STAGE(PG8_SB(1, 0), b3, voffB); PG8_STAGE(PG8_SB(1, 1), b3 + hB, voffB); PG8_STAGE(PG8_SA(1, 0), a3, voffA);
            PG8_WAIT_V(8); PG8_WAIT_L(0); PG8_BAR; PG8_MMA(1, 0, At, B0); PG8_MMA(1, 1, At, B1); PG8_BAR; PG8_SCHED;
            } else {
            PG8_LDB(B0, 0, 0); PG8_SCHED; PG8_LDA(At, 0, 0); PG8_STAGE(PG8_SA(1, 1), a1 + hA, voffA);
            PG8_WAIT_L(8); PG8_BAR; PG8_WAIT_L(0); PG8_MMA(0, 0, At, B0); PG8_BAR; PG8_SCHED;
            PG8_LDB(B1, 0, 1); PG8_STAGE(PG8_SB(0, 0), b2, voffB);
            PG8_BAR; PG8_WAIT_L(0); PG8_MMA(0, 1, At, B1); PG8_BAR;
            PG8_LDA(At, 0, 1); PG8_STAGE(PG8_SA(0, 0), a2, voffA);
            PG8_BAR; PG8_WAIT_L(0); PG8_MMA(1, 0, At, B0); PG8_BAR; PG8_SCHED;
            PG8_STAGE(PG8_SB(0, 1), b2 + hB, voffB);
            PG8_WAIT_V(6); PG8_BAR; PG8_MMA(1, 1, At, B1); PG8_BAR;
            PG8_LDB(B0, 1, 0); PG8_SCHED; PG8_LDA(At, 1, 0); PG8_STAGE(PG8_SA(0, 1), a2 + hA, voffA);
            PG8_WAIT_L(8); PG8_BAR; PG8_WAIT_L(0); PG8_MMA(0, 0, At, B0); PG8_BAR; PG8_SCHED;
            PG8_LDB(B1, 1, 1); PG8_STAGE(PG8_SB(1, 0), b3, voffB);
            PG8_BAR; PG8_WAIT_L(0); PG8_MMA(0, 1, At, B1); PG8_BAR;
            PG8_LDA(At, 1, 1); PG8_STAGE(PG8_SA(1, 0), a3, voffA);
            PG8_BAR; PG8_WAIT_L(0); PG8_MMA(1, 0, At, B0); PG8_BAR; PG8_SCHED;
            PG8_STAGE(PG8_SB(1, 1), b3 + hB, voffB);
            PG8_WAIT_V(6); PG8_BAR; PG8_MMA(1, 1, At, B1); PG8_BAR;
            }
        }
        if constexpr (ALIGN_EPI) { if (wr == 0) PG8_BAR; }
        E(acc, cur, wr, wc, fr, fq, ui, has_next, nxt); S.done(cur);
        if (!has_next) break;
#pragma unroll
        for (int a = 0; a < 2; ++a)
#pragma unroll
            for (int b = 0; b < 2; ++b)
#pragma unroll
                for (int m = 0; m < 4; ++m)
#pragma unroll
                    for (int n = 0; n < 2; ++n) acc[a][b][m][n] = (f32x4){0.f, 0.f, 0.f, 0.f};
        cur = nxt; cA = nA; cB = nB; ++ui;
        if constexpr (ALIGN_EPI) { if (wr == 1) PG8_BAR; }
    }
    PG8_WAIT_V(0);
    if constexpr (!ALIGN_EPI) { if (wr == 0) PG8_BAR; }
    PG8_BAR;
#undef PG8_SA
#undef PG8_SB
#undef PG8_STAGE
#undef PG8_LDA
#undef PG8_LDB
#undef PG8_MMA
#undef PG8_WAIT_V
#undef PG8_WAIT_L
#undef PG8_BAR
#undef PG8_SCHED
}


struct EpiResid {
    static constexpr bool PERM = true;
    const float* xin32; float* xout32; bf16_t* xb; float* ss;
    __device__ __forceinline__ void prime(const Unit&, int) const {}
    __device__ __forceinline__ void operator()(f32x4 (&acc)[2][2][4][2], const Unit& u, int wr, int wc, int fr, int fq, int, bool, const Unit&) const {
        const int row0 = u.pm * BM + wr * 64 + fr, col0 = u.pn * BM + wc * 32 + 8 * fq;
#pragma unroll
        for (int ai = 0; ai < 2; ++ai)
#pragma unroll
            for (int m = 0; m < 4; ++m) {
                const int row = row0 + ai * HALF + m * 16; const size_t off = (size_t)row * DM + col0; float s = 0.f;
#pragma unroll
                for (int bj = 0; bj < 2; ++bj) {
                    f32x4 x0, x1;
                    if (xin32) { x0 = *(const f32x4*)(xin32 + off + bj * HALF); x1 = *(const f32x4*)(xin32 + off + bj * HALF + 4); }
                    else { const u32x4 xv = *(const u32x4*)(xb + off + bj * HALF);
                        x0 = (f32x4){__builtin_bit_cast(float, xv.x << 16), __builtin_bit_cast(float, xv.x & 0xffff0000u), __builtin_bit_cast(float, xv.y << 16), __builtin_bit_cast(float, xv.y & 0xffff0000u)};
                        x1 = (f32x4){__builtin_bit_cast(float, xv.z << 16), __builtin_bit_cast(float, xv.z & 0xffff0000u), __builtin_bit_cast(float, xv.w << 16), __builtin_bit_cast(float, xv.w & 0xffff0000u)}; }
                    const f32x4 v0 = acc[ai][bj][m][0] + x0, v1 = acc[ai][bj][m][1] + x1;
                    if (xout32) { *(f32x4*)(xout32 + off + bj * HALF) = v0; *(f32x4*)(xout32 + off + bj * HALF + 4) = v1; }
                    u32x4 w; w.x = cvt_pk_bf16(v0[0], v0[1]); w.y = cvt_pk_bf16(v0[2], v0[3]); w.z = cvt_pk_bf16(v1[0], v1[1]); w.w = cvt_pk_bf16(v1[2], v1[3]);
                    *(u32x4*)(xb + off + bj * HALF) = w;
                    s += (v0[0] * v0[0] + v0[1] * v0[1]) + (v0[2] * v0[2] + v0[3] * v0[3]) + (v1[0] * v1[0] + v1[1] * v1[1]) + (v1[2] * v1[2] + v1[3] * v1[3]);
                }
                s += shfl_xor_f(s, 16); s += shfl_xor_f(s, 32);
                if (fq == 0 && ss) unsafeAtomicAdd(ss + row, s);
                if (m == 3) asm volatile("" ::: "memory");
            }
    }
};

struct EpiUp {
    static constexpr bool PERM = true;
    bf16_t* act; const float* ss; const float* cw; const float* cb; float* convp; LAS float* pl; int layer;
    struct CP { f32x4 w0a, w1a, w2a, cba, w0b, w1b, w2b, cbb; };
    static constexpr int PLB = 8 * 32 * 4 + 256;
    __device__ __forceinline__ CP ldcp(const LAS float* p, int cq) const { CP c; const LAS f32x4* q = (const LAS f32x4*)p + cq;
        c.w0a = q[0]; c.w1a = q[32]; c.w2a = q[64]; c.cba = q[96]; c.w0b = q[128]; c.w1b = q[160]; c.w2b = q[192]; c.cbb = q[224]; return c; }
    __device__ __forceinline__ f32x4 fetch(const Unit& u, int tid) const {
        if (tid < 256) { const int arr = tid >> 5, f = 128 * u.pn + 4 * (tid & 31) + (arr >= 4 ? DFF : 0), a3 = arr & 3;
            return a3 == 3 ? *(const f32x4*)(cb + f) : *(const f32x4*)(cw + a3 * DUP + f); }
        const float sv = ss[252 * u.pm - 2 + (tid - 256)]; return (f32x4){__builtin_amdgcn_rsqf(sv * (1.f / DM) + NORM_EPS), 0.f, 0.f, 0.f};
    }
    __device__ __forceinline__ void stash(LAS float* p, int tid, const f32x4 v) const { if (tid < 256) ((LAS f32x4*)p)[tid] = v; else p[8 * 32 * 4 + (tid - 256)] = v[0]; }
    __device__ __forceinline__ void prime(const Unit& u, int tid) const { asm volatile("" : "+v"(tid)); stash(pl, tid, fetch(u, tid)); }
    template <bool SQS>
    __device__ __forceinline__ void body(f32x4 (&acc)[2][2][4][2], int t0, int f0, int fr, const LAS float* pc, int cq) const {
#pragma unroll
        for (int n = 0; n < 2; ++n) {
            const int fa = f0 + 4 * n; const CP c = ldcp(pc, cq + n);
            f32x4 ua2 = dpp_shr1(acc[1][0][2][n]), ua1 = dpp_shr1(acc[1][0][3][n]), ub2 = dpp_shr1(acc[1][1][2][n]), ub1 = dpp_shr1(acc[1][1][3][n]);
#pragma unroll
            for (int e = 0; e < 8; ++e) {
                const f32x4 ua = acc[e >> 2][0][e & 3][n], ub = acc[e >> 2][1][e & 3][n];
                f32x4 xa1 = ua1, xa2 = ua2, xb1 = ub1, xb2 = ub2;
                if (SQS) { const int pos = (t0 + e) & (SEQ - 1); const f32x4 z = (f32x4){0.f, 0.f, 0.f, 0.f};
                    if (pos < 1) { xa1 = z; xb1 = z; } if (pos < 2) { xa2 = z; xb2 = z; } }
                const f32x4 ca = c.cba + c.w2a * ua + c.w1a * xa1 + c.w0a * xa2, cv = c.cbb + c.w2b * ub + c.w1b * xb1 + c.w0b * xb2;
                float r[4];
#pragma unroll
                for (int q = 0; q < 4; ++q) { const float ex = __builtin_amdgcn_exp2f(-LOG2E * ca[q]); r[q] = ca[q] * __builtin_amdgcn_rcpf(1.f + ex) * cv[q]; }
                const int t = t0 + e;
                if (t >= 0 && t < MTOK && !(fr == 0 && e < 2)) { u32x2 w; w.x = cvt_pk_bf16(r[0], r[1]); w.y = cvt_pk_bf16(r[2], r[3]); *(u32x2*)(act + (size_t)t * DFF + fa) = w; }
                ua2 = ua1; ua1 = ua; ub2 = ub1; ub1 = ub;
            }
            __builtin_amdgcn_sched_barrier(0);
        }
    }
    __device__ __forceinline__ void body_smp(f32x4 (&acc)[2][2][4][2], int b0, int f0, const LAS float* pc, int cq) const {
        const unsigned long long hv = ((volatile LAS unsigned long long*)((LAS unsigned char*)pl - 1024 + 64))[IN_SCONV];
        const unsigned long long hp = ((unsigned long long)__builtin_amdgcn_readfirstlane((unsigned)(hv >> 32)) << 32) | (unsigned)__builtin_amdgcn_readfirstlane((unsigned)hv);
        const float* hist = (const float*)(const GAS float*)hp + (size_t)layer * NSMP * 2 * DUP;
        float* convs = convp + ((long)O_CONVS - (long)O_CONVP) + (long)layer * (NSMP - NBATCH) * 2 * DUP;
        bf16_t* acts = (bf16_t*)((unsigned char*)act + (WS_SMP + SM_ACT - WS_ACT));
#pragma unroll
        for (int n = 0; n < 2; ++n) {
            const int fa = f0 + 4 * n; const CP c = ldcp(pc, cq + n);
#pragma unroll
            for (int e = 0; e < 8; ++e) { const unsigned hb = (unsigned)((b0 + e) * 2 * DUP + fa);
                const f32x4 ua = acc[e >> 2][0][e & 3][n], ub = acc[e >> 2][1][e & 3][n];
                const f32x4 h0a = *(const f32x4*)(hist + hb), h1a = *(const f32x4*)(hist + hb + DUP), h0b = *(const f32x4*)(hist + hb + DFF), h1b = *(const f32x4*)(hist + hb + DUP + DFF);
                const f32x4 ca = c.cba + c.w2a * ua + c.w1a * h1a + c.w0a * h0a, cv = c.cbb + c.w2b * ub + c.w1b * h1b + c.w0b * h0b;
                float r[4];
#pragma unroll
                for (int q = 0; q < 4; ++q) { const float ex = __builtin_amdgcn_exp2f(-LOG2E * ca[q]); r[q] = ca[q] * __builtin_amdgcn_rcpf(1.f + ex) * cv[q]; }
                u32x2 w; w.x = cvt_pk_bf16(r[0], r[1]); w.y = cvt_pk_bf16(r[2], r[3]); *(u32x2*)(acts + (unsigned)((b0 + e) * DFF + fa)) = w;
                *(f32x4*)(convs + hb) = h1a; *(f32x4*)(convs + hb + DUP) = ua; *(f32x4*)(convs + hb + DFF) = h1b; *(f32x4*)(convs + hb + DUP + DFF) = ub;
                __builtin_amdgcn_sched_barrier(0);
            }
        }
    }
    __device__ __forceinline__ void operator()(f32x4 (&acc)[2][2][4][2], const Unit& u, int wr, int wc, int fr, int fq, int ui, bool has_next, const Unit& nxt) const {
        const int T0 = 252 * u.pm + 126 * wr - 2; int tid = (4 * wr + wc) * 64 + 16 * fq + fr;
        asm volatile("" : "+v"(tid));
        const int wr2 = tid >> 8, wc2 = (tid >> 6) & 3, fq2 = (tid >> 4) & 3, fr2 = tid & 15, t0 = T0 + 8 * fr2, f0 = 128 * u.pn + 32 * wc2 + 8 * fq2;
        const LAS float* pc = pl + (ui & 1) * PLB;
        f32x4 nv = {0.f, 0.f, 0.f, 0.f}; if (has_next) nv = fetch(nxt, tid);
        {
#pragma unroll
            for (int e = 0; e < 8; ++e) { const float rs = pc[8 * 32 * 4 + 126 * wr2 + 8 * fr2 + e];
#pragma unroll
                for (int bj = 0; bj < 2; ++bj)
#pragma unroll
                    for (int n = 0; n < 2; ++n) acc[e >> 2][bj][e & 3][n] *= rs; }
        }
        __builtin_amdgcn_sched_barrier(0);
        if (T0 >= 0 && ((T0 & (SEQ - 1)) >= SEQ - 2 - 127)) {
#pragma unroll
            for (int e = 0; e < 8; ++e) { const int t = t0 + e, pos = t & (SEQ - 1);
                if (t < MTOK && pos >= SEQ - 2 && !(fr2 == 0 && e < 2)) { float* dst = convp + ((size_t)(t >> 11) * 2 + (pos - (SEQ - 2))) * DUP + f0;
#pragma unroll
                    for (int n = 0; n < 2; ++n) { *(f32x4*)(dst + 4 * n) = acc[e >> 2][0][e & 3][n]; *(f32x4*)(dst + DFF + 4 * n) = acc[e >> 2][1][e & 3][n]; } } }
        }
        __builtin_amdgcn_sched_barrier(0);
        const int z = ((T0 + SEQ) >> 11) << 11;
        if (u.pm == 65 && wr == 1) body_smp(acc, 8 * fr2, f0, pc, 8 * wc2 + 2 * fq2);
        else if (z <= T0 + 127) body<true>(acc, t0, f0, fr2, pc, 8 * wc2 + 2 * fq2); else body<false>(acc, t0, f0, fr2, pc, 8 * wc2 + 2 * fq2);
        if (has_next) stash(pl + ((ui + 1) & 1) * PLB, tid, nv);
    }
};

struct EpiQKV {
    static constexpr bool PERM = true;
    const float* ss; const float* rot; unsigned char* wsb; float* outb; const float* kgain; long qgain_delta; float qscale; int qtile0; const LAS float* rotd;
    __device__ __forceinline__ void prime(const Unit&, int) const {}
    __device__ __forceinline__ void operator()(f32x4 (&acc)[2][2][4][2], const Unit& u, int wr, int wc, int fr, int fq, int, bool, const Unit&) const {
        const int pn = u.pn; const int type = pn >= qtile0 ? 2 : (pn >= 6 ? 1 : 0);
        const int pl = type == 2 ? pn - qtile0 : (type == 1 ? pn - 6 : pn), g = pl >> 1, h = 4 * (pl & 1) + wc;
        bf16_t* dstb = (bf16_t*)(wsb + (type == 0 ? WS_KB : (type == 1 ? WS_VB : WS_QB)));
        const int win = g == 0 ? 128 : (g == 1 ? 512 : 2048); float* kvo = outb + (g == 0 ? O_KV128P : (g == 1 ? O_KV512P : O_KV2048P));
        f32x4 g0 = {1.f, 1.f, 1.f, 1.f}, g1 = g0, g2 = g0, g3 = g0;
        if (type != 1) { const float* gp = (const float*)((const char*)kgain + (type == 0 ? 0l : qgain_delta)) + 16 * fq; const float sc = type == 2 ? qscale : 1.f;
            g0 = *(const f32x4*)gp * sc; g1 = *(const f32x4*)(gp + 4) * sc; g2 = *(const f32x4*)(gp + 8) * sc; g3 = *(const f32x4*)(gp + 12) * sc; }
        const int row0 = u.pm * BM + wr * 64 + fr, cbase = g * 512 + h * 64 + 16 * fq;
        float ssv[8];
#pragma unroll
        for (int e = 0; e < 8; ++e) ssv[e] = ss[row0 + (e >> 2) * HALF + (e & 3) * 16];
        f32x4 bc0 = {1.f, 1.f, 1.f, 1.f}, bc1 = bc0, bs0 = {0.f, 0.f, 0.f, 0.f}, bs1 = bs0;
        if (type != 1 && fq == 0) { const float* rp = rot + (size_t)(u.pm == 64 ? SEQ : (row0 & (SEQ - 1))) * 16;
            bc0 = *(const f32x4*)(rp); bc1 = *(const f32x4*)(rp + 4); bs0 = *(const f32x4*)(rp + 8); bs1 = *(const f32x4*)(rp + 12); }
#pragma unroll
        for (int ai = 0; ai < 2; ++ai)
#pragma unroll
            for (int m = 0; m < 4; ++m) {
                const int row = row0 + ai * HALF + m * 16; const bool smp = u.pm == 64; const int pos = smp ? SEQ : (row & (SEQ - 1)), b = smp ? row - SMP_ROW0 : (row >> 11);
                const float rs = __builtin_amdgcn_rsqf(ssv[4 * ai + m] * (1.f / DM) + NORM_EPS);
                f32x4 v0 = acc[ai][0][m][0] * rs, v1 = acc[ai][0][m][1] * rs, v2 = acc[ai][1][m][0] * rs, v3 = acc[ai][1][m][1] * rs;
                if (type != 1) {
                    const f32x4 q4 = v0 * v0 + v1 * v1 + v2 * v2 + v3 * v3; float sq = (q4[0] + q4[1]) + (q4[2] + q4[3]);
                    sq += shfl_xor_f(sq, 16); sq += shfl_xor_f(sq, 32);
                    const float inv = __builtin_amdgcn_rsqf(sq * (1.f / HD) + NORM_EPS);
                    v0 = v0 * inv * g0; v1 = v1 * inv * g1; v2 = v2 * inv * g2; v3 = v3 * inv * g3;
                    if (fq == 0) { const LAS float* dp = rotd + (smp ? 0 : (4 * ai + m) * 16);
                        const f32x4 dc0 = *(const LAS f32x4*)(dp), dc1 = *(const LAS f32x4*)(dp + 4), ds0 = *(const LAS f32x4*)(dp + 8), ds1 = *(const LAS f32x4*)(dp + 12);
                        const f32x4 c0 = bc0 * dc0 - bs0 * ds0, c1 = bc1 * dc1 - bs1 * ds1, s0 = bs0 * dc0 + bc0 * ds0, s1 = bs1 * dc1 + bc1 * ds1;
                        const f32x4 a0 = v0, a1 = v1, b0 = v2, b1 = v3;
                        v0 = a0 * c0 - b0 * s0; v1 = a1 * c1 - b1 * s1; v2 = b0 * c0 + a0 * s0; v3 = b1 * c1 + a1 * s1; }
                }
                if (smp) {
                    if (b >= 0 && b < NSMP) { float* d = (float*)(wsb + WS_SMP + (type == 0 ? SM_KN : (type == 1 ? SM_VN : SM_Q))) + (size_t)b * QW + cbase;
                        *(f32x4*)(d) = v0; *(f32x4*)(d + 4) = v1; *(f32x4*)(d + 8) = v2; *(f32x4*)(d + 12) = v3;
                        if (type != 2) { float* o = outb + (g == 0 ? O_KV128S : (g == 1 ? O_KV512S : O_KV2048S)) + ((size_t)b * 2 + type) * OW + h * 64 + 16 * fq;
                            *(f32x4*)(o) = v0; *(f32x4*)(o + 4) = v1; *(f32x4*)(o + 8) = v2; *(f32x4*)(o + 12) = v3; } }
                } else {
                    u32x4 w0, w1; w0.x = cvt_pk_bf16(v0[0], v0[1]); w0.y = cvt_pk_bf16(v0[2], v0[3]); w0.z = cvt_pk_bf16(v1[0], v1[1]); w0.w = cvt_pk_bf16(v1[2], v1[3]);
                    w1.x = cvt_pk_bf16(v2[0], v2[1]); w1.y = cvt_pk_bf16(v2[2], v2[3]); w1.z = cvt_pk_bf16(v3[0], v3[1]); w1.w = cvt_pk_bf16(v3[2], v3[3]);
                    bf16_t* d = dstb + (size_t)row * QW + cbase; *(u32x4*)d = w0; *(u32x4*)(d + 8) = w1;
                    if (type != 2) { const int rr = pos - (SEQ - win);
                        if (rr >= 0) { float* o = kvo + (((size_t)b * win + rr) * 2 + type) * OW + h * 64 + 16 * fq;
                            *(f32x4*)(o) = v0; *(f32x4*)(o + 4) = v1; *(f32x4*)(o + 8) = v2; *(f32x4*)(o + 12) = v3; } }
                }
                if (m & 1) asm volatile("" ::: "memory");
            }
    }
};
}
#define XB_TMO      128
#define XB_XCNT(j)  (256  + 64 * (j))
#define XB_XSUB(j)  (1280 + 64 * (j))
#define XB_XGEN(j)  (2304 + 64 * (j))
#define XB_TOP      3328
#define XB_TOPGEN   3392
#define XCD_BAR_WORDS 3456
#define XB_SPIN_CAP (1u << 18)

__device__ __forceinline__ unsigned xb_ld(unsigned* p)              { return __hip_atomic_load(p, __ATOMIC_RELAXED, __HIP_MEMORY_SCOPE_AGENT); }
__device__ __forceinline__ unsigned xb_add(unsigned* p, unsigned v) { return __hip_atomic_fetch_add(p, v, __ATOMIC_RELAXED, __HIP_MEMORY_SCOPE_AGENT); }
__device__ __forceinline__ unsigned xb_xcc_id() { return (unsigned)__builtin_amdgcn_s_getreg((3 << 11) | 20) & 0xFu; }
#define XB_SPIN(cond, bar) do { unsigned _sp = 0; while (cond) { __builtin_amdgcn_s_sleep(1); \
    if ((++_sp & 255u) == 0u) { if (xb_ld(&(bar)[XB_TMO])) break; if (_sp > XB_SPIN_CAP) { atomicAdd(&(bar)[XB_TMO], 1u); break; } } } } while (0)

struct XcdBarrier {
    unsigned* bar; unsigned x;
    volatile LAS unsigned* st;
};

__device__ __forceinline__ XcdBarrier xcd_barrier_post(unsigned* bar, volatile LAS unsigned* st) {
    XcdBarrier b; b.bar = bar; b.x = xb_xcc_id(); b.st = st;
    if (threadIdx.x == 0) (void)xb_add(&bar[XB_XCNT(b.x)], 1u);
    return b;
}
__device__ __forceinline__ void xcd_barrier_complete(unsigned* bar, unsigned x, unsigned& nloc, unsigned& nx) {
    const unsigned G = gridDim.x * gridDim.y * gridDim.z;
    unsigned sum, cnt, mine, sp = 0u;
    for (;;) {
        sum = 0u; cnt = 0u; mine = 0u;
#pragma unroll
        for (unsigned j = 0; j < 16; ++j) { const unsigned c = xb_ld(&bar[XB_XCNT(j)]); sum += c; cnt += (c > 0u) ? 1u : 0u; mine = (j == x) ? c : mine; }
        if (sum == G) break;
        __builtin_amdgcn_s_sleep(1);
        if ((++sp & 255u) == 0u) { if (xb_ld(&bar[XB_TMO])) break; if (sp > XB_SPIN_CAP) { atomicAdd(&bar[XB_TMO], 1u); break; } }
    }
    nloc = mine > 0u ? mine : 1u; nx = cnt > 0u ? cnt : 1u;
}

__device__ __forceinline__ void xcd_barrier(const XcdBarrier& b) {
    asm volatile("s_waitcnt vmcnt(0)" ::: "memory");
    __syncthreads();
    if (threadIdx.x == 0) {
        unsigned* bar = b.bar;
        __builtin_amdgcn_s_waitcnt(0);
        unsigned nloc = b.st[0], nx = b.st[1];
        if (nloc == 0u) { xcd_barrier_complete(bar, b.x, nloc, nx); b.st[0] = nloc; b.st[1] = nx; }
        const unsigned old = xb_add(&bar[XB_XSUB(b.x)], 1u);
        const unsigned gen = old / nloc;
        if (old + 1u == (gen + 1u) * nloc) {
            __builtin_amdgcn_fence(__ATOMIC_RELEASE, "agent");
            asm volatile("s_waitcnt vmcnt(0)" ::: "memory");
            const unsigned og = xb_add(&bar[XB_TOP], 1u);
            const unsigned tg = og / nx;
            if (og + 1u == (tg + 1u) * nx) xb_add(&bar[XB_TOPGEN], 1u);
            else XB_SPIN(xb_ld(&bar[XB_TOPGEN]) == tg, bar);
            __builtin_amdgcn_fence(__ATOMIC_ACQUIRE, "agent");
            xb_add(&bar[XB_XGEN(b.x)], 1u);
            asm volatile("s_waitcnt vmcnt(0)" ::: "memory");
        } else {
            XB_SPIN(xb_ld(&bar[XB_XGEN(b.x)]) == gen, bar);
            __builtin_amdgcn_fence(__ATOMIC_ACQUIRE, "agent");
            asm volatile("s_waitcnt vmcnt(0)" ::: "memory");
        }
    }
    __syncthreads();
}

struct Frame {
    LAS unsigned char* lds;
    volatile LAS unsigned* MISC;
    gu32* ctl; float* ctlf;
    int tid, lane, wave, vcu, G, bx;
    float* out; unsigned char* ws;
};
constexpr int PTAB_OFF = LDSCTL_OFF + 64;
__device__ __forceinline__ unsigned long long ptab_get(const Frame& F, int i) {
    const unsigned long long v = ((volatile LAS unsigned long long*)(F.lds + PTAB_OFF))[i];
    const unsigned lo = __builtin_amdgcn_readfirstlane((unsigned)v), hi = __builtin_amdgcn_readfirstlane((unsigned)(v >> 32));
    return ((unsigned long long)hi << 32) | lo;
}
__device__ __forceinline__ const float* inp(const Frame& F, int i) { return (const float*)(const GAS float*)ptab_get(F, i); }
__device__ __forceinline__ float* ptab_out(const Frame& F) { return (float*)(GAS float*)ptab_get(F, N_IN); }
__device__ __forceinline__ unsigned char* ptab_ws(const Frame& F) { return (unsigned char*)(GAS unsigned char*)ptab_get(F, N_IN + 1); }
__device__ __forceinline__ float* ssp(const Frame& F, int stage) { return F.ctlf + CW_SSP + stage * SS_STRIDE + SS_FRONT; }
__device__ __forceinline__ float* sss(const Frame& F, int stage) { return ssp(F, stage) + SMP_ROW0; }
__device__ __forceinline__ bf16_t* xsb_ptr(const Frame& F) { return (bf16_t*)(F.ws + WS_XB) + (XB_PAD_ROWS + SMP_ROW0) * DM; }

template <int RM> __device__ __forceinline__ int rowof(int n) {
    if (RM == 0) return n;
    if (RM == 1) { const int isb = n >= DFF ? 1 : 0; const int f = n - DFF * isb; return 256 * (f >> 7) + 128 * isb + (f & 127); }
    const int tile = n >> 8, hh = (n >> 6) & 3, e = n & 63; return 256 * tile + 128 * ((e >> 3) & 1) + 32 * hh + 8 * (e >> 4) + (e & 7);
}
struct WJob { const float* W; int K, ldw; bf16_t* WT; int row_off; const float* kscale; const float* nscale; int rm, kb, nb; };
constexpr int WT_UP = 16 * (DUP / 256), WT_DN = (DFF / 64) * (DM / 256), WT_KV = 16 * (KVW / 256), WT_Q = 16 * (QW / 256), WT_O = (OW / 64) * (DM / 256), WT_P = 8 * 4;
constexpr int WSEG0 = 0, WSEG1 = WT_P + WT_UP, WSEG2 = WSEG1 + 2 * WT_DN + WT_UP, WSEG2B = WSEG2 + WT_KV + WT_Q, WSEG3B = WSEG2B + 2 * WT_O + WT_UP + WT_DN + WT_Q, WSEG4 = WSEG3B + WT_UP + WT_DN;
__device__ __forceinline__ void wjob_up(const Frame& F, int l, int r, WJob& j) { const int nbk = DUP / 256;
    j.W = inp(F, IN_WUP) + (size_t)l * DM * DUP; j.K = DM; j.ldw = DUP; j.WT = (bf16_t*)(F.ws + WS_WUP) + (size_t)l * DUP * DM; j.kscale = inp(F, IN_GFFN) + l * DM; j.rm = 1; j.kb = r / nbk; j.nb = r % nbk; }
__device__ __forceinline__ void wjob_dn(const Frame& F, int l, int r, WJob& j) { const int nbk = DM / 256;
    j.W = inp(F, IN_WDOWN) + (size_t)l * DFF * DM; j.K = DFF; j.ldw = DM; j.WT = (bf16_t*)(F.ws + WS_WDOWN) + (size_t)l * DM * DFF; j.kb = r / nbk; j.nb = r % nbk; }
__device__ __forceinline__ void wjob_q(const Frame& F, int jj, int r, WJob& j) { const int nbk = QW / 256;
    j.W = inp(F, IN_WQ) + (size_t)jj * DM * QW; j.K = DM; j.ldw = QW; j.WT = jj == 0 ? (bf16_t*)(F.ws + WS_WKVQ) : (bf16_t*)(F.ws + WS_WQ3); j.row_off = jj == 0 ? KVW : 0; j.kscale = inp(F, IN_GATTN) + jj * DM; j.rm = 2;
    j.kb = r / nbk; j.nb = r % nbk; }
__device__ __forceinline__ void wjob_o(const Frame& F, int jj, int r, WJob& j) { const int nbk = DM / 256;
    j.W = inp(F, IN_WO) + (size_t)jj * OW * DM; j.K = OW; j.ldw = DM; j.WT = (bf16_t*)(F.ws + WS_WO) + (size_t)jj * DM * OW; j.kb = r / nbk; j.nb = r % nbk; }
__device__ __forceinline__ bool wjob_get(const Frame& F, int it, int it_end, WJob& j) {
    if (it >= it_end) return false;
    int r = it; j.row_off = 0; j.kscale = nullptr; j.nscale = nullptr; j.rm = 0;
    if (r < WT_P) { const int lg = r >> 2;
        j.W = inp(F, IN_WPOOL) + (size_t)lg * 65536; j.K = 256; j.ldw = 256; j.WT = (bf16_t*)(F.ws + WS_WP) + (size_t)lg * 65536; j.nscale = inp(F, IN_PSCALE) + lg * 256; j.kb = r & 3; j.nb = 0; return true; }
    r -= WT_P;
    if (r < WT_UP) { wjob_up(F, 0, r, j); return true; } r -= WT_UP;
    if (r < WT_DN) { wjob_dn(F, 0, r, j); return true; } r -= WT_DN;
    if (r < WT_UP) { wjob_up(F, 1, r, j); return true; } r -= WT_UP;
    if (r < WT_DN) { wjob_dn(F, 1, r, j); return true; } r -= WT_DN;
    if (r < WT_KV) { const int nbk = KVW / 256;
        j.W = inp(F, IN_WKV); j.K = DM; j.ldw = KVW; j.WT = (bf16_t*)(F.ws + WS_WKVQ); j.kscale = inp(F, IN_GKV); j.rm = 2; j.kb = r / nbk; j.nb = r % nbk; return true; }
    r -= WT_KV;
    if (r < WT_Q) { wjob_q(F, 0, r, j); return true; } r -= WT_Q;
    if (r < WT_O) { wjob_o(F, 0, r, j); return true; } r -= WT_O;
    if (r < WT_O) { wjob_o(F, 1, r, j); return true; } r -= WT_O;
    if (r < WT_UP) { wjob_up(F, 2, r, j); return true; } r -= WT_UP;
    if (r < WT_DN) { wjob_dn(F, 2, r, j); return true; } r -= WT_DN;
    if (r < WT_Q) { wjob_q(F, 1, r, j); return true; } r -= WT_Q;
    if (r < WT_UP) { wjob_up(F, 3, r, j); return true; } r -= WT_UP;
    wjob_dn(F, 3, r, j); return true;
}
__device__ __forceinline__ void wjob_load(const WJob& j, int wave, int lane, f32x4 (&v)[8]) {
#pragma unroll
    for (int i = 0; i < 8; ++i) v[i] = __builtin_nontemporal_load((const f32x4*)(j.W + (size_t)(64 * j.kb + 8 * wave + i) * j.ldw + 256 * j.nb + 4 * lane));
}
__device__ __forceinline__ void wtile_step(Frame& F, const WJob& cur, const f32x4 (&v)[8], LAS float* scr) {
    { const f32x4 ns = cur.nscale ? *(const f32x4*)(cur.nscale + 256 * cur.nb + 4 * F.lane) : (f32x4){1.f, 1.f, 1.f, 1.f};
#pragma unroll
        for (int i = 0; i < 8; ++i) { const int kk = 8 * F.wave + i; const float ks = cur.kscale ? cur.kscale[64 * cur.kb + kk] : 1.f; const f32x4 x = v[i] * ns * ks;
            LAS float* d = scr + kk * 257 + 4 * F.lane; d[0] = x[0]; d[1] = x[1]; d[2] = x[2]; d[3] = x[3]; } }
    __syncthreads();
#pragma unroll
    for (int q = 0; q < 4; ++q) { const int id = F.tid + 512 * q, n = id >> 3, c = id & 7; const LAS float* s = scr + (8 * c) * 257 + n;
        u32x4 o; o.x = pk2(s[0 * 257], s[1 * 257]); o.y = pk2(s[2 * 257], s[3 * 257]); o.z = pk2(s[4 * 257], s[5 * 257]); o.w = pk2(s[6 * 257], s[7 * 257]);
        const int nl = 256 * cur.nb + n; const int row = cur.rm == 0 ? rowof<0>(nl) : (cur.rm == 1 ? rowof<1>(nl) : rowof<2>(nl));
        *(u32x4*)(cur.WT + (size_t)(cur.row_off + row) * cur.K + 64 * cur.kb + 8 * c) = o; }
    __syncthreads();
}
__device__ __forceinline__ void convert_weights(Frame& F, int it0, int it1, int cu_lo, int cu_hi = 1 << 30) {
    if (cu_hi > F.G) cu_hi = F.G;
    if (F.bx < cu_lo || F.bx >= cu_hi || it0 >= it1) return;
    LAS float* scr = (LAS float*)(F.lds + RING_OFF);
    const int stride = cu_hi - cu_lo;
    WJob cur, nxt; int it = it0 + (F.bx - cu_lo); bool have = wjob_get(F, it, it1, cur); f32x4 va[8], vb[8];
    if (have) wjob_load(cur, F.wave, F.lane, va);
    while (have) {
        bool more = wjob_get(F, it + stride, it1, nxt);
        if (more) wjob_load(nxt, F.wave, F.lane, vb);
        wtile_step(F, cur, va, scr);
        if (!more) break;
        cur = nxt; it += stride;
        more = wjob_get(F, it + stride, it1, nxt);
        if (more) wjob_load(nxt, F.wave, F.lane, va);
        wtile_step(F, cur, vb, scr);
        cur = nxt; have = more; it += stride;
    }
}
__device__ __forceinline__ void p0_weights(Frame& F) {
    convert_weights(F, WSEG0, WSEG1, 0);
    float* rot = (float*)(F.ws + WS_ROT);
    if (F.wave == 0) { for (int e = F.vcu * 64 + F.lane; e < 2049 * 8; e += F.G * 64) { const int pos = e >> 3, i = e & 7;
        const double invf = i == 0 ? 1.0 : i == 1 ? 0.19392274474868576 : i == 2 ? 0.03760603093086393 : i == 3 ? 0.007292664737217109 : i == 4 ? 0.001414213562373095 : i == 5 ? 0.0002742481756762073 : i == 6 ? 5.318295896944988e-05 : 1.031338537721246e-05;
        const double ang = (double)pos * invf, n = __builtin_rint(ang * 0.15915494309189535);
        const double r = __builtin_fma(-n, 1.2246467991473532e-16 * 2.0, __builtin_fma(-n, 6.283185307179586, ang));
        const float rf = (float)r; rot[pos * 16 + i] = cosf(rf); rot[pos * 16 + 8 + i] = sinf(rf); } }
    { u32x4* xb = (u32x4*)(F.ws + WS_XB); const u32x4 z = {0u, 0u, 0u, 0u}; const size_t n0 = XB_PAD_ROWS * 128, n1 = XB_TAIL_ROWS * 128, tail = (XB_PAD_ROWS + MTOK) * 128;
        for (size_t i = (size_t)F.vcu * 512 + F.tid; i < n0 + n1; i += (size_t)F.G * 512) xb[i < n0 ? i : tail + (i - n0)] = z; }
}

template <bool XBF16> __device__ __forceinline__ f32x4 ld_x4(const void* x, size_t row, int col) {
    if (XBF16) { const u32x2 v = *(const u32x2*)((const bf16_t*)x + row * DM + col);
        return (f32x4){__builtin_bit_cast(float, v.x << 16), __builtin_bit_cast(float, v.x & 0xffff0000u), __builtin_bit_cast(float, v.y << 16), __builtin_bit_cast(float, v.y & 0xffff0000u)}; }
    return *(const f32x4*)((const float*)x + row * DM + col);
}
template <bool SELF_RSTD, bool XBF16>
__device__ __forceinline__ void pool_d_phase(Frame& F, const void* x, const float* ssin, const float* gpool, bf16_t* dbuf, float* pool_out) {
    LAS float* rs = (LAS float*)(F.lds + RING_OFF);
    for (int item = F.vcu; item < NBATCH * 32; item += F.G) {
        const int b = item >> 5, p0 = 64 * (item & 31); const size_t rowbase = (size_t)b * SEQ;
        if (SELF_RSTD) {
#pragma unroll
            for (int half = 0; half < 2; ++half) {
                f32x4 v[5][4];
#pragma unroll
                for (int jj = 0; jj < 5; ++jj) { const int i = F.wave + 8 * (5 * half + jj), p = p0 - 15 + i;
                    if (i < 79 && p >= 0) {
#pragma unroll
                        for (int j = 0; j < 4; ++j) v[jj][j] = ld_x4<XBF16>(x, rowbase + p, 4 * F.lane + 256 * j); } }
#pragma unroll
                for (int jj = 0; jj < 5; ++jj) { const int i = F.wave + 8 * (5 * half + jj), p = p0 - 15 + i;
                    if (i < 79 && p >= 0) { float s = 0.f;
#pragma unroll
                        for (int j = 0; j < 4; ++j) s += (v[jj][j][0] * v[jj][j][0] + v[jj][j][1] * v[jj][j][1]) + (v[jj][j][2] * v[jj][j][2] + v[jj][j][3] * v[jj][j][3]);
                        s = wave_sum(s); if (F.lane == 0) rs[i] = 1.0f / sqrtf(s * (1.f / DM) + NORM_EPS); } }
            }
        } else {
            if (F.tid < 79) { const int p = p0 - 15 + F.tid; if (p >= 0) rs[F.tid] = 1.0f / sqrtf(ssin[rowbase + p] * (1.f / DM) + NORM_EPS); }
        }
        __syncthreads();
        {
            const int q = F.tid >> 8, c4 = F.tid & 255, col = 4 * c4, w = 2 << (c4 >> 6), pstart = p0 + 32 * q, ro = p0 - 15;
            const f32x4 gp = *(const f32x4*)(gpool + col);
            f32x4 S = {0.f, 0.f, 0.f, 0.f};
            if (pstart == 0) {
                for (int p = 0; p < 32; ++p) {
                    const f32x4 xn = ld_x4<XBF16>(x, rowbase + p, col) * rs[p - ro] * gp;
                    S += xn;
                    if (p - w >= 0) S -= ld_x4<XBF16>(x, rowbase + p - w, col) * rs[p - w - ro] * gp;
                    const int cnt = (p + 1) < w ? (p + 1) : w; const f32x4 d = S * (1.0f / (float)cnt) - xn;
                    u32x2 o; o.x = pk2(d[0], d[1]); o.y = pk2(d[2], d[3]); *(u32x2*)(dbuf + (rowbase + p) * DM + col) = o;
                }
            } else {
                {
                    f32x4 xw[15];
#pragma unroll
                    for (int k = 0; k < 15; ++k) { xw[k] = (f32x4){0.f, 0.f, 0.f, 0.f}; if (15 - k <= w - 1) xw[k] = ld_x4<XBF16>(x, rowbase + pstart - 15 + k, col); }
#pragma unroll
                    for (int k = 0; k < 15; ++k) if (15 - k <= w - 1) S += xw[k] * rs[pstart - 15 + k - ro] * gp;
                }
                const float invw = 1.0f / (float)w;
#pragma unroll 1
                for (int i0 = 0; i0 < 32; i0 += 8) {
                    f32x4 xa[8], xo[8];
#pragma unroll
                    for (int k = 0; k < 8; ++k) { const int p = pstart + i0 + k; xa[k] = ld_x4<XBF16>(x, rowbase + p, col); xo[k] = ld_x4<XBF16>(x, rowbase + p - w, col); }
#pragma unroll
                    for (int k = 0; k < 8; ++k) { const int p = pstart + i0 + k; const f32x4 xn = xa[k] * rs[p - ro] * gp;
                        S += xn; if (i0 + k > 0) S -= xo[k] * rs[p - w - ro] * gp;
                        const f32x4 d = S * invw - xn;
                        u32x2 o; o.x = pk2(d[0], d[1]); o.y = pk2(d[2], d[3]); *(u32x2*)(dbuf + (rowbase + p) * DM + col) = o;
                        if (p >= SEQ - PHIST) *(f32x4*)(pool_out + ((size_t)b * PHIST + (p - (SEQ - PHIST))) * DM + col) = xn; }
                }
            }
        }
        __syncthreads();
    }
}

struct ALoadBf16 { const bf16_t* A; int lda; int acol0;
    __device__ __forceinline__ bf16x8 operator()(int row, int k) const { return *(const bf16x8*)(A + (size_t)row * lda + acol0 + k); } };
struct ALoadAttn { const float* op; const float* lp;
    __device__ __forceinline__ bf16x8 operator()(int row, int k) const {
        const int h = k >> 6; float l = 0.f; f32x4 a = {0.f, 0.f, 0.f, 0.f}, b = {0.f, 0.f, 0.f, 0.f};
#pragma unroll
        for (int g = 0; g < 6; ++g) { l += lp[(g * 128 + row) * 8 + h]; const float* p = op + ((size_t)g * 128 + row) * OW + k; a += *(const f32x4*)p; b += *(const f32x4*)(p + 4); }
        const float inv = 1.0f / l; a *= inv; b *= inv;
        u32x4 w; w.x = pk2(a[0], a[1]); w.y = pk2(a[2], a[3]); w.z = pk2(b[0], b[1]); w.w = pk2(b[2], b[3]); return __builtin_bit_cast(bf16x8, w); } };

template <int NT, int CH, class AL, class BRow, class Epi>
__device__ __forceinline__ void mini_gemm_item(Frame& F, const AL& al, const bf16_t* Bt, int K, const BRow& brow, int rb, const Epi& epi) {
    LAS float* red = (LAS float*)(F.lds + RING_OFF);
    const int w = F.wave, fr = F.lane & 15, fq = F.lane >> 4, ksub = K >> 3, k0 = w * ksub;
    f32x4 acc[2][NT]; int br[NT];
#pragma unroll
    for (int nt = 0; nt < NT; ++nt) { br[nt] = brow(16 * nt + fr); acc[0][nt] = (f32x4){0.f, 0.f, 0.f, 0.f}; acc[1][nt] = (f32x4){0.f, 0.f, 0.f, 0.f}; }
    constexpr int NQ_ = 4 * NT; const int tt_ = F.tid % (32 * NQ_);
    const auto pre = epi.prefetch(rb * 32 + tt_ / NQ_, 4 * (tt_ % NQ_));
    for (int kk0 = 0; kk0 < ksub; kk0 += 32 * CH) {
        bf16x8 a[CH][2], bb[CH][NT];
#pragma unroll
        for (int s = 0; s < CH; ++s) if (kk0 + 32 * s < ksub) {
#pragma unroll
            for (int mt = 0; mt < 2; ++mt) a[s][mt] = al(rb * 32 + 16 * mt + fr, k0 + kk0 + 32 * s + 8 * fq);
#pragma unroll
            for (int nt = 0; nt < NT; ++nt) bb[s][nt] = *(const bf16x8*)(Bt + (size_t)br[nt] * K + k0 + kk0 + 32 * s + 8 * fq); }
#pragma unroll
        for (int s = 0; s < CH; ++s) if (kk0 + 32 * s < ksub) {
#pragma unroll
            for (int mt = 0; mt < 2; ++mt)
#pragma unroll
                for (int nt = 0; nt < NT; ++nt) acc[mt][nt] = __builtin_amdgcn_mfma_f32_16x16x32_bf16(a[s][mt], bb[s][nt], acc[mt][nt], 0, 0, 0); }
    }
#pragma unroll
    for (int mt = 0; mt < 2; ++mt)
#pragma unroll
        for (int nt = 0; nt < NT; ++nt)
#pragma unroll
            for (int i = 0; i < 4; ++i) red[(w * 32 + 16 * mt + 4 * fq + i) * (16 * NT) + 16 * nt + fr] = acc[mt][nt][i];
    __syncthreads();
    constexpr int NQ = 4 * NT;
    {
        const int t = F.tid % (32 * NQ); const bool live = F.tid < 32 * NQ; const int row = t / NQ, cq = t % NQ; f32x4 s = {0.f, 0.f, 0.f, 0.f};
#pragma unroll
        for (int w8 = 0; w8 < 8; ++w8) s += *(const LAS f32x4*)(red + (w8 * 32 + row) * (16 * NT) + 4 * cq);
        epi(rb * 32 + row, 4 * cq, s, live, pre);
    }
    __syncthreads();
}
template <int NQ> __device__ __forceinline__ float rowred(float v) {
#pragma unroll
    for (int o = 1; o < NQ; o <<= 1) v += shfl_xor_f(v, o);
    return v;
}
template <int NQ> struct SmpResid { const float* xin; float* xout; bf16_t* xb; float* ss; int c0;
    __device__ __forceinline__ f32x4 prefetch(int row, int jj0) const { return *(const f32x4*)(xin + (size_t)row * DM + c0 + jj0); }
    __device__ __forceinline__ void operator()(int row, int jj0, f32x4 s, bool live, f32x4 xold) const {
        const size_t off = (size_t)row * DM + c0 + jj0; const f32x4 v = xold + s;
        if (live) { *(f32x4*)(xout + off) = v; u32x2 o; o.x = pk2(v[0], v[1]); o.y = pk2(v[2], v[3]); *(u32x2*)(xb + off) = o; }
        const float q = rowred<NQ>((v[0] * v[0] + v[1] * v[1]) + (v[2] * v[2] + v[3] * v[3]));
        if (live && ss && (jj0 == 0)) unsafeAtomicAdd(ss + row, q); } };
struct BRowNat { int r0; __device__ __forceinline__ int operator()(int jj) const { return r0 + jj; } };

__device__ __forceinline__ void smp_pool_d(Frame& F, int layer, const float* xs, bool self_rstd, const float* ssin) {
    const int gwr = (F.G - 1 - F.bx) * NWAVES + F.wave, NGW = F.G * NWAVES;
    const float* gpool = inp(F, IN_GPOOL) + layer * DM; bf16_t* ds = (bf16_t*)(F.ws + WS_SMP + SM_DS);
    const float* spool = inp(F, IN_SPOOL);
    for (int task = gwr; task < NSMP * 4; task += NGW) { const int b = task >> 2, j = task & 3;
        const int col = 256 * j + 4 * F.lane, w = 2 << j;
        const float* hist = spool + ((size_t)layer * NSMP + b) * PHIST * DM + col; float* po = F.out + O_POOLS + ((size_t)layer * NSMP + b) * PHIST * DM + col;
        const f32x4* xr = (const f32x4*)(xs + (size_t)b * DM) + F.lane; f32x4 v[4], hv[PHIST];
#pragma unroll
        for (int jj = 0; jj < 4; ++jj) v[jj] = xr[64 * jj];
#pragma unroll
        for (int i = 0; i < PHIST; ++i) hv[i] = *(const f32x4*)(hist + (size_t)i * DM);
        float s = 0.f;
#pragma unroll
        for (int jj = 0; jj < 4; ++jj) s += (v[jj][0] * v[jj][0] + v[jj][1] * v[jj][1]) + (v[jj][2] * v[jj][2] + v[jj][3] * v[jj][3]);
        s = self_rstd ? wave_sum(s) : ssin[b];
        const float r = 1.0f / sqrtf(s * (1.f / DM) + NORM_EPS);
        const f32x4 xj = j == 0 ? v[0] : (j == 1 ? v[1] : (j == 2 ? v[2] : v[3]));
        const f32x4 xn = xj * r * *(const f32x4*)(gpool + col); f32x4 S = xn;
#pragma unroll
        for (int i = 0; i < PHIST; ++i) { if (i >= PHIST - (w - 1)) S += hv[i]; if (i >= 1) *(f32x4*)(po + (size_t)(i - 1) * DM) = hv[i]; }
        *(f32x4*)(po + (size_t)(PHIST - 1) * DM) = xn;
        const f32x4 d = S * (1.0f / (float)w) - xn; u32x2 o; o.x = pk2(d[0], d[1]); o.y = pk2(d[2], d[3]); *(u32x2*)(ds + (size_t)b * DM + col) = o;
    }
}
struct ALoadBf16Coh { const bf16_t* A; int lda;
    __device__ __forceinline__ bf16x8 operator()(int row, int k) const { unsigned long long* p = (unsigned long long*)(A + (size_t)row * lda + k);
        const unsigned long long lo = __hip_atomic_load(p, RLX_AGENT), hi = __hip_atomic_load(p + 1, RLX_AGENT);
        const u32x4 w = {(unsigned)lo, (unsigned)(lo >> 32), (unsigned)hi, (unsigned)(hi >> 32)}; return __builtin_bit_cast(bf16x8, w); } };
__device__ __forceinline__ void smp_attn_finalize(Frame& F, int layer) {
    if (F.wave != 0) return;
    const float* op = (const float*)(F.ws + WS_SMP + SM_OP); const float* lp = (const float*)(F.ws + WS_SMP + SM_LP); bf16_t* oa = (bf16_t*)(F.ws + WS_SMP + SM_OA);
    for (int task = F.bx; task < 2 * NSMP; task += F.G) { const int row = task >> 1, col = 256 * (task & 1) + 4 * F.lane, h = col >> 6;
        float l = 0.f; f32x4 a = {0.f, 0.f, 0.f, 0.f};
#pragma unroll
        for (int g = 0; g < 6; ++g) { l += lp[(g * 128 + row) * 8 + h]; a += *(const f32x4*)(op + ((size_t)g * 128 + row) * OW + col); }
        a *= 1.0f / l;
        const unsigned long long w = (unsigned long long)pk2(a[0], a[1]) | ((unsigned long long)pk2(a[2], a[3]) << 32);
        __hip_atomic_store((unsigned long long*)(oa + (size_t)row * OW + col), w, RLX_AGENT);
        asm volatile("s_waitcnt vmcnt(0)" ::: "memory");
        if (F.lane == 0) __hip_atomic_fetch_add((unsigned*)F.ctl + CW_SUB + layer, 1u, RLX_AGENT);
    }
}
__device__ __forceinline__ void smp_mixer_gemm(Frame& F, int layer, const float* xin, float* xout, float* ssout) {
    bf16_t* xsb = xsb_ptr(F);
    for (int it = F.G - 1 - F.bx; it < 4 * 64; it += F.G) { const int rb = it & 3, cb = it >> 2;
        const SmpResid<4> E{xin, xout, xsb, ssout, 16 * cb};
        if (layer < 2) { const int grp = cb >> 4; const ALoadBf16 al{(const bf16_t*)(F.ws + WS_SMP + SM_DS), DM, 256 * grp};
            mini_gemm_item<1, 12>(F, al, (const bf16_t*)(F.ws + WS_WP) + (size_t)layer * 4 * 65536, 256, BRowNat{16 * cb}, rb, E); }
        else { if (F.tid == 0) { unsigned* ctr = (unsigned*)F.ctl + CW_SUB + layer; unsigned* bar = (unsigned*)F.ctl + CW_BAR; XB_SPIN(xb_ld(ctr) < 2u * NSMP, bar); }
            __syncthreads();
            const ALoadBf16Coh al{(const bf16_t*)(F.ws + WS_SMP + SM_OA), OW};
            mini_gemm_item<1, 12>(F, al, (const bf16_t*)(F.ws + WS_WO) + (size_t)(layer - 2) * DM * OW, OW, BRowNat{16 * cb}, rb, E); }
    }
}
struct BRowUp { int f0; __device__ __forceinline__ int operator()(int jj) const { return rowof<1>((jj & 1) * DFF + f0 + (jj >> 1)); } };
struct SmpUpPre { f32x2 h0a, h1a, h0b, h1b, w0a, w1a, w2a, w0b, w1b, w2b, ba, bb; float ssv; };
struct SmpUp { const float* ss; const float* cw; const float* cb; const float* hist; float* convs; bf16_t* act; int f0;
    __device__ __forceinline__ SmpUpPre prefetch(int row, int jj0) const { SmpUpPre p; const int fa = f0 + (jj0 >> 1), fb = fa + DFF;
        p.h0a = *(const f32x2*)(hist + (size_t)(row * 2 + 0) * DUP + fa); p.h1a = *(const f32x2*)(hist + (size_t)(row * 2 + 1) * DUP + fa);
        p.h0b = *(const f32x2*)(hist + (size_t)(row * 2 + 0) * DUP + fb); p.h1b = *(const f32x2*)(hist + (size_t)(row * 2 + 1) * DUP + fb);
        p.w0a = *(const f32x2*)(cw + fa); p.w1a = *(const f32x2*)(cw + DUP + fa); p.w2a = *(const f32x2*)(cw + 2 * DUP + fa);
        p.w0b = *(const f32x2*)(cw + fb); p.w1b = *(const f32x2*)(cw + DUP + fb); p.w2b = *(const f32x2*)(cw + 2 * DUP + fb);
        p.ba = *(const f32x2*)(cb + fa); p.bb = *(const f32x2*)(cb + fb); p.ssv = ss[row]; return p; }
    __device__ __forceinline__ void operator()(int row, int jj0, f32x4 s, bool live, const SmpUpPre& p) const {
        if (!live) return;
        const float rs = 1.0f / sqrtf(p.ssv * (1.f / DM) + NORM_EPS); const int f = f0 + (jj0 >> 1);
        const f32x2 ua = (f32x2){s[0], s[2]} * rs, ub = (f32x2){s[1], s[3]} * rs;
        const f32x2 ca = p.ba + p.w0a * p.h0a + p.w1a * p.h1a + p.w2a * ua, cv = p.bb + p.w0b * p.h0b + p.w1b * p.h1b + p.w2b * ub;
        const float r0 = ca[0] / (1.f + __expf(-ca[0])) * cv[0], r1 = ca[1] / (1.f + __expf(-ca[1])) * cv[1];
        *(f32x2*)(convs + (size_t)(row * 2 + 0) * DUP + f) = p.h1a; *(f32x2*)(convs + (size_t)(row * 2 + 1) * DUP + f) = ua;
        *(f32x2*)(convs + (size_t)(row * 2 + 0) * DUP + f + DFF) = p.h1b; *(f32x2*)(convs + (size_t)(row * 2 + 1) * DUP + f + DFF) = ub;
        *(unsigned*)(act + (size_t)row * DFF + f) = pk2(r0, r1); } };
__device__ __forceinline__ void smp_up(Frame& F, int layer, const float* ssin) {
    for (int it = F.G - 1 - F.bx; it < 4 * (DFF / 32); it += F.G) { const int rb = it & 3, cb = it >> 2;
        const ALoadBf16 al{xsb_ptr(F), DM, 0};
        const SmpUp E{ssin, inp(F, IN_CONVW) + (size_t)layer * 3 * DUP, inp(F, IN_CONVB) + (size_t)layer * DUP, inp(F, IN_SCONV) + (size_t)layer * NSMP * 2 * DUP,
                      F.out + O_CONVS + (size_t)layer * NSMP * 2 * DUP, (bf16_t*)(F.ws + WS_SMP + SM_ACT), 32 * cb};
        mini_gemm_item<4, 4>(F, al, (const bf16_t*)(F.ws + WS_WUP) + (size_t)layer * DUP * DM, DM, BRowUp{32 * cb}, rb, E); }
}
__device__ __forceinline__ void smp_down(Frame& F, int layer, const float* xin, float* xout, float* ssout) {
    for (int it = F.G - 1 - F.bx; it < 4 * 64; it += F.G) { const int rb = it & 3, cb = it >> 2;
        const ALoadBf16 al{(const bf16_t*)(F.ws + WS_SMP + SM_ACT), DFF, 0};
        const SmpResid<4> E{xin, xout, xsb_ptr(F), ssout, 16 * cb};
        mini_gemm_item<1, 12>(F, al, (const bf16_t*)(F.ws + WS_WDOWN) + (size_t)layer * DM * DFF, DFF, BRowNat{16 * cb}, rb, E); }
}
struct BRowHead { int base; __device__ __forceinline__ int operator()(int jj) const { return base + 128 * (jj >> 5) + (jj & 31); } };
struct SmpQKV { const float* ss; const float* rot; const float* gain; float scale; int type; float* dst; float* kvo; int hcol;
    __device__ __forceinline__ int prefetch(int, int) const { return 0; }
    __device__ __forceinline__ void operator()(int row, int jj0, f32x4 s, bool live, int) const {
        const float rs = 1.0f / sqrtf(ss[row] * (1.f / DM) + NORM_EPS); const int bj = jj0 >> 5, r0 = jj0 & 31, d0 = 16 * (r0 >> 3) + 8 * bj + (r0 & 7);
        f32x4 v = s * rs;
        if (type != 1) {
            const float sq = rowred<16>((v[0] * v[0] + v[1] * v[1]) + (v[2] * v[2] + v[3] * v[3])); const float inv = 1.0f / sqrtf(sq * (1.f / HD) + NORM_EPS);
            v = v * inv * *(const f32x4*)(gain + d0);
            f32x4 pv; pv[0] = shfl_xor_f(v[0], 8); pv[1] = shfl_xor_f(v[1], 8); pv[2] = shfl_xor_f(v[2], 8); pv[3] = shfl_xor_f(v[3], 8);
            if (r0 < 8) { const float* rp = rot + (size_t)SEQ * 16 + (r0 & 7); const f32x4 c = *(const f32x4*)rp, sn = *(const f32x4*)(rp + 8);
                v = bj == 0 ? v * c - pv * sn : v * c + pv * sn; }
            v *= scale;
        }
        if (live) { *(f32x4*)(dst + (size_t)row * QW + hcol + d0) = v; if (kvo) *(f32x4*)(kvo + ((size_t)row * 2 + type) * OW + d0) = v; } } };
__device__ __forceinline__ void smp_qkv(Frame& F, int layer, const float* ssin) {
    const int nhead = layer == 2 ? 72 : 24;
    const bf16_t* W = layer == 2 ? (const bf16_t*)(F.ws + WS_WKVQ) : (const bf16_t*)(F.ws + WS_WQ3);
    const float* rot = (const float*)(F.ws + WS_ROT);
    for (int it = F.G - 1 - F.bx; it < 4 * nhead; it += F.G) { const int rb = it & 3, hd = it >> 2;
        const int tile = hd >> 2, hh = hd & 3; const int type = layer == 2 ? (tile >= 12 ? 2 : (tile >= 6 ? 1 : 0)) : 2;
        const int pl = layer == 2 ? (type == 2 ? tile - 12 : (type == 1 ? tile - 6 : tile)) : tile; const int g = pl >> 1, h = 4 * (pl & 1) + hh;
        const ALoadBf16 al{xsb_ptr(F), DM, 0};
        float* dst = (float*)(F.ws + WS_SMP + (type == 0 ? SM_KN : (type == 1 ? SM_VN : SM_Q)));
        float* kvo = type == 2 ? nullptr : F.out + (g == 0 ? O_KV128S : (g == 1 ? O_KV512S : O_KV2048S)) + h * 64;
        const SmpQKV E{ssin, rot, type == 0 ? inp(F, IN_KGAIN) : inp(F, IN_QGAIN) + (layer - 2) * HD, type == 2 ? 0.125f * LOG2E : 1.f, type, dst, kvo, g * 512 + h * 64};
        mini_gemm_item<4, 4>(F, al, W, DM, BRowHead{256 * tile + 32 * hh}, rb, E); }
}
__device__ __forceinline__ float softmax_offset(const Frame& F, int j) {
    const float a = fabsf(inp(F, IN_QGAIN)[j * HD + F.lane]), b = fabsf(inp(F, IN_KGAIN)[F.lane]); float ma = a, mb = b;
#pragma unroll
    for (int o = 1; o < 64; o <<= 1) { ma = fmaxf(ma, shfl_xor_f(ma, o)); mb = fmaxf(mb, shfl_xor_f(mb, o)); }
    return 8.0f * ma * mb * LOG2E;
}
__device__ __forceinline__ void smp_attn(Frame& F, int j) {
    LAS float* red = (LAS float*)(F.lds + RING_OFF);
    const float m0 = softmax_offset(F, j);
    const float* qs = (const float*)(F.ws + WS_SMP + SM_Q); const float* kn = (const float*)(F.ws + WS_SMP + SM_KN); const float* vn = (const float*)(F.ws + WS_SMP + SM_VN);
    float* op = (float*)(F.ws + WS_SMP + SM_OP); float* lp = (float*)(F.ws + WS_SMP + SM_LP);
    for (int it = F.G - 1 - F.bx; it < NSMP * 3; it += F.G) { const int b = it / 3, g = it % 3;
        const int dil = g == 0 ? 1 : (g == 1 ? 4 : 16), nbuf = g == 0 ? 128 : (g == 1 ? 512 : 2048);
        const float* c0p = inp(F, IN_C128); const float* c1p = inp(F, IN_C512); const float* c2p = inp(F, IN_C2048);
        const float* cache = (g == 0 ? c0p : (g == 1 ? c1p : c2p)) + (size_t)b * nbuf * 1024;
        f32x4 q[2], o[2]; float ls[2] = {0.f, 0.f};
#pragma unroll
        for (int jj = 0; jj < 2; ++jj) { q[jj] = *(const f32x4*)(qs + (size_t)b * QW + g * 512 + 256 * jj + 4 * F.lane); o[jj] = (f32x4){0.f, 0.f, 0.f, 0.f}; }
        for (int kq = F.wave * 16; kq < F.wave * 16 + 16; kq += 4) {
            f32x4 kv[4][4];
#pragma unroll
            for (int r = 0; r < 4; ++r) { const f32x4* rowp = (const f32x4*)(cache + (size_t)(kq + r) * dil * 1024) + F.lane;
#pragma unroll
                for (int c = 0; c < 4; ++c) kv[r][c] = __builtin_nontemporal_load(rowp + 64 * c); }
#pragma unroll
            for (int r = 0; r < 4; ++r)
#pragma unroll
                for (int jj = 0; jj < 2; ++jj) { const f32x4 k = kv[r][jj]; float s = (k[0] * q[jj][0] + k[1] * q[jj][1]) + (k[2] * q[jj][2] + k[3] * q[jj][3]);
                    s = rowred<16>(s); const float p = __builtin_amdgcn_exp2f(s - m0); ls[jj] += p; o[jj] += kv[r][2 + jj] * p; }
        }
        if (F.wave == 0) {
#pragma unroll
            for (int jj = 0; jj < 2; ++jj) { const f32x4 k = *(const f32x4*)(kn + (size_t)b * QW + g * 512 + 256 * jj + 4 * F.lane), v = *(const f32x4*)(vn + (size_t)b * QW + g * 512 + 256 * jj + 4 * F.lane);
                float s = (k[0] * q[jj][0] + k[1] * q[jj][1]) + (k[2] * q[jj][2] + k[3] * q[jj][3]); s = rowred<16>(s); const float p = __builtin_amdgcn_exp2f(s - m0); ls[jj] += p; o[jj] += v * p; }
        }
#pragma unroll
        for (int jj = 0; jj < 2; ++jj) { *(LAS f32x4*)(red + F.wave * 576 + 256 * jj + 4 * F.lane) = o[jj]; if ((F.lane & 15) == 0) red[F.wave * 576 + 512 + 4 * jj + (F.lane >> 4)] = ls[jj]; }
        __syncthreads();
        for (int e = F.tid; e < 520; e += 512) { float s = 0.f;
#pragma unroll
            for (int w8 = 0; w8 < 8; ++w8) s += red[w8 * 576 + e];
            if (e < 512) op[((size_t)g * NSMP + b) * OW + e] = s; else lp[((size_t)g * NSMP + b) * 8 + (e - 512)] = s; }
        __syncthreads();
    }
}

namespace att {
constexpr int ROWB = 128, BUFB = 256 * ROWB;
constexpr int SRED_OFF = RING_BYTES + 1024;
typedef short v4i16_t __attribute__((ext_vector_type(4)));
__device__ __forceinline__ s16x4 vtr(LAS const unsigned char* p) { return __builtin_bit_cast(s16x4, __builtin_amdgcn_ds_read_tr16_b64_v4i16((LAS v4i16_t*)p)); }
__device__ __forceinline__ int k_off(int buf) { return buf == 0 ? 0 : 3 * BUFB; }
__device__ __forceinline__ int v_off(int buf) { return buf == 0 ? BUFB : 2 * BUFB; }

__device__ __forceinline__ void wave_task(LAS const unsigned char* kb, LAS const unsigned char* vb, const bf16x8 (&qf)[2], int krw, int c_lo, int c_hi, int lo, int hi, int kmin, float m0, f32x4 (&O)[4], float& lsum, int lane) {
    const int fr = lane & 15, fq = lane >> 4;
    const f32x4 cinit = {-m0, -m0, -m0, -m0};
    int koff[2][2], voff[4][2];
#pragma unroll
    for (int t = 0; t < 2; ++t)
#pragma unroll
        for (int ks = 0; ks < 2; ++ks) koff[t][ks] = ((fq + 4 * ks) ^ ((fr & 3) + 4 * t)) << 4;
#pragma unroll
    for (int dt = 0; dt < 4; ++dt)
#pragma unroll
        for (int hf = 0; hf < 2; ++hf) voff[dt][hf] = (((2 * dt + ((fr & 3) >> 1)) ^ ((fr >> 2) + 4 * hf)) << 4) + 8 * (fr & 1);
    if (c_lo >= c_hi) return;
    const unsigned vbase = (unsigned)(__UINTPTR_TYPE__)vb + (unsigned)((krw + 8 * fq + (fr >> 2)) * ROWB);
    const int krowb = krw + 8 * (fr >> 2) + (fr & 3);
    bf16x8 kf[2][2];
#pragma unroll
    for (int t = 0; t < 2; ++t)
#pragma unroll
        for (int ks = 0; ks < 2; ++ks) kf[t][ks] = *(const LAS bf16x8*)(kb + (krowb + 32 * c_lo + 4 * t) * ROWB + koff[t][ks]);
    for (int c = c_lo; c < c_hi; ++c) {
        const unsigned va = vbase + (unsigned)(32 * c * ROWB);
        s16x4 vlo[4], vhi[4];
#pragma unroll
        for (int dt = 0; dt < 4; ++dt) {
            asm volatile("ds_read_b64_tr_b16 %0, %1" : "=&v"(vlo[dt]) : "v"(va + (unsigned)voff[dt][0]) : "memory");
            asm volatile("ds_read_b64_tr_b16 %0, %1" : "=&v"(vhi[dt]) : "v"(va + (unsigned)(4 * ROWB + voff[dt][1])) : "memory"); }
        f32x4 S[2];
#pragma unroll
        for (int t = 0; t < 2; ++t) { S[t] = __builtin_amdgcn_mfma_f32_16x16x32_bf16(kf[t][0], qf[0], cinit, 0, 0, 0); S[t] = __builtin_amdgcn_mfma_f32_16x16x32_bf16(kf[t][1], qf[1], S[t], 0, 0, 0); }
        { const int cn = c + 1 < c_hi ? c + 1 : c;
#pragma unroll
            for (int t = 0; t < 2; ++t)
#pragma unroll
                for (int ks = 0; ks < 2; ++ks) kf[t][ks] = *(const LAS bf16x8*)(kb + (krowb + 32 * cn + 4 * t) * ROWB + koff[t][ks]); }
        float p[8];
#pragma unroll
        for (int t = 0; t < 2; ++t)
#pragma unroll
            for (int i = 0; i < 4; ++i) { const int kk = 32 * c + 8 * fq + 4 * t + i, dlt = kk - fr; const bool ok = dlt >= lo && dlt <= hi && kk >= kmin;
                const float e = __builtin_amdgcn_exp2f(S[t][i]); p[4 * t + i] = ok ? e : 0.f; lsum += p[4 * t + i]; }
        u32x4 pw; pw.x = cvt_pk_bf16(p[0], p[1]); pw.y = cvt_pk_bf16(p[2], p[3]); pw.z = cvt_pk_bf16(p[4], p[5]); pw.w = cvt_pk_bf16(p[6], p[7]);
        const bf16x8 pb = __builtin_bit_cast(bf16x8, pw);
        asm volatile("s_waitcnt lgkmcnt(0)" ::: "memory"); __builtin_amdgcn_sched_barrier(0);
#pragma unroll
        for (int dt = 0; dt < 4; ++dt) {
            const bf16x8 vf = {vlo[dt][0], vlo[dt][1], vlo[dt][2], vlo[dt][3], vhi[dt][0], vhi[dt][1], vhi[dt][2], vhi[dt][3]};
            O[dt] = __builtin_amdgcn_mfma_f32_16x16x32_bf16(vf, pb, O[dt], 0, 0, 0);
        }
    }
}
struct Pass { int g, ps, s, nsub; bool first, last;
    int hc, tok0, nlo_shift, step_hi, step_lo, krvalid0; };
__device__ __forceinline__ Pass pass_desc(int P, int jq, int h) {
    Pass d; d.nsub = 1; d.s = 0; d.first = true; d.last = true;
    if (P < 8) { d.g = P >> 2; d.ps = P & 3; const int dil = d.g == 0 ? 1 : 4, r = d.g == 0 ? 0 : d.ps, l0 = d.g == 0 ? 512 * jq + 128 * d.ps : 128 * jq;
        d.hc = d.g * 512 + h * 64; d.tok0 = (l0 - 128) * dil + r; d.nlo_shift = 8; d.step_hi = 0; d.step_lo = dil; d.krvalid0 = l0 >= 128 ? 0 : 128; }
    else { d.g = 2; d.nsub = (32 * jq + 32 > 64) ? 2 : 1; const int q = P - 8; d.ps = d.nsub == 2 ? (q >> 1) : q; d.s = d.nsub == 2 ? (q & 1) : 0; d.first = d.s == 0; d.last = d.s == d.nsub - 1;
        d.hc = 2 * 512 + h * 64; d.tok0 = 16 * 64 * d.s + 4 * d.ps; d.nlo_shift = 6; d.step_hi = 1; d.step_lo = 16; d.krvalid0 = 0; }
    return d;
}
__device__ __forceinline__ void stage_dma(LAS unsigned char* lds, const Pass& d, int buf, const bf16_t* Kb, const bf16_t* Vb, const bf16_t* zrow, size_t rowbase, int w, int lane) {
    const int ch = (lane & 7) ^ (lane >> 3);
#pragma unroll
    for (int it = 0; it < 4; ++it) { const int kr0 = 64 * it + 8 * w, kr = kr0 + (lane >> 3);
        const int tok = d.tok0 + (kr >> d.nlo_shift) * d.step_hi + (kr & ((1 << d.nlo_shift) - 1)) * d.step_lo;
        const size_t off = (rowbase + tok) * QW + d.hc + 8 * ch; const bool ok = kr >= d.krvalid0;
        const bf16_t* ks = ok ? Kb + off : zrow + 8 * ch; const bf16_t* vs = ok ? Vb + off : zrow + 8 * ch;
        __builtin_amdgcn_global_load_lds((const unsigned*)ks, (LAS unsigned*)(lds + k_off(buf) + kr0 * ROWB), 16, 0, 0);
        __builtin_amdgcn_global_load_lds((const unsigned*)vs, (LAS unsigned*)(lds + v_off(buf) + kr0 * ROWB), 16, 0, 0); }
}
__device__ __forceinline__ int task_qtok(const Pass& d, int jq, int w, int fr) {
    if (d.g < 2) { const int dil = d.g == 0 ? 1 : 4, r = d.g == 0 ? 0 : d.ps, l0 = d.g == 0 ? 512 * jq + 128 * d.ps : 128 * jq; return (l0 + 16 * w + fr) * dil + r; }
    return 16 * (32 * jq + 16 * (w & 1) + fr) + 4 * d.ps + (w >> 1);
}

__device__ __forceinline__ void phase(Frame& F, int j) {
    LAS unsigned char* lds = F.lds + RING_OFF;
    LAS float* sred = (LAS float*)(F.lds + SRED_OFF);
    const float m0 = softmax_offset(F, j);
    const bf16_t* Qb = (const bf16_t*)(F.ws + WS_QB); const bf16_t* Kb = (const bf16_t*)(F.ws + WS_KB); const bf16_t* Vb = (const bf16_t*)(F.ws + WS_VB); bf16_t* Ob = (bf16_t*)(F.ws + WS_OB);
    const bf16_t* zrow = (const bf16_t*)(F.ws + WS_XB);
    bf16_t* opart = (bf16_t*)(F.ws + WS_OPART);
    float* lpart = (float*)(F.ws + WS_LPART);
    const float* qs = (const float*)(F.ws + WS_SMP + SM_Q); const float* kn = (const float*)(F.ws + WS_SMP + SM_KN); const float* vn = (const float*)(F.ws + WS_SMP + SM_VN);
    float* sop = (float*)(F.ws + WS_SMP + SM_OP); float* slp = (float*)(F.ws + WS_SMP + SM_LP);
    const float* c0p = inp(F, IN_C128); const float* c1p = inp(F, IN_C512); const float* c2p = inp(F, IN_C2048);
    const int lane = F.lane, fr = lane & 15, fq = lane >> 4, w = F.wave;
    for (int i = F.tid; i < 16 * ROWB / 4; i += 512) { ((LAS unsigned*)(lds + v_off(1)))[i] = 0u; ((LAS unsigned*)(lds + k_off(1)))[i] = 0u; }
    for (int unit = F.vcu; unit < 256; unit += F.G) {
        const int b = unit >> 5, h = (unit >> 2) & 7, jq = unit & 3; const size_t rowbase = (size_t)b * SEQ;
        const int np = 8 + 4 * ((32 * jq + 32 > 64) ? 2 : 1);
        const int hi0 = 3 * unit; constexpr int n_sl = 12;
        f32x4 sq[2], so[2]; float sl_[2] = {0.f, 0.f};
        so[0] = (f32x4){0.f, 0.f, 0.f, 0.f}; so[1] = so[0]; sq[0] = so[0]; sq[1] = so[0];
        bf16x8 qn[2];
        { const Pass d0 = pass_desc(0, jq, h); stage_dma(lds, d0, 0, Kb, Vb, zrow, rowbase, w, lane);
            const bf16_t* qp = Qb + (rowbase + task_qtok(d0, jq, w, fr)) * QW + d0.hc + 8 * fq; qn[0] = *(const bf16x8*)qp; qn[1] = *(const bf16x8*)(qp + 32);
        }
        __syncthreads();
        f32x4 O[4]; float lsum = 0.f; bf16x8 qf[2];
        f32x4 Opend[4]; float lpend = 0.f; size_t ppend = 0; bool pend = false;
#define ATT_FLUSH() do { if (pend) { bf16_t* op_ = opart + ppend * OW + h * 64 + 4 * fq; \
            _Pragma("unroll") for (int dt = 0; dt < 4; ++dt) { u32x2 pw_; pw_.x = cvt_pk_bf16(Opend[dt][0], Opend[dt][1]); pw_.y = cvt_pk_bf16(Opend[dt][2], Opend[dt][3]); *(u32x2*)(op_ + 16 * dt) = pw_; } \
            if (fq == 0) lpart[ppend * 8 + h] = lpend; pend = false; } } while (0)
        for (int P = 0; P < np; ++P) {
            const Pass d = pass_desc(P, jq, h);
            ATT_FLUSH();
            if (d.first) { qf[0] = qn[0]; qf[1] = qn[1]; lsum = 0.f;
#pragma unroll
                for (int dt = 0; dt < 4; ++dt) O[dt] = (f32x4){0.f, 0.f, 0.f, 0.f}; }
            const bool more = P + 1 < np;
            if (more) { const Pass dn = pass_desc(P + 1, jq, h); stage_dma(lds, dn, (P + 1) & 1, Kb, Vb, zrow, rowbase, w, lane);
                if (dn.first) { const bf16_t* qp = Qb + (rowbase + task_qtok(dn, jq, w, fr)) * QW + dn.hc + 8 * fq; qn[0] = *(const bf16x8*)qp; qn[1] = *(const bf16x8*)(qp + 32); } }
            const int sl = P; const bool has_sl = sl < n_sl; f32x4 kv[2][4];
            const int shi = hi0 + (sl >> 2), sit = shi >> 1, shalf = shi & 1, sb = sit / 3, sg = sit - 3 * sb;
            if (has_sl) { const int dil = sg == 0 ? 1 : (sg == 1 ? 4 : 16), nbuf = sg == 0 ? 128 : (sg == 1 ? 512 : 2048);
                const float* cache = (sg == 0 ? c0p : (sg == 1 ? c1p : c2p)) + (size_t)sb * nbuf * 1024;
                if ((sl & 3) == 0) {
#pragma unroll
                    for (int jj = 0; jj < 2; ++jj) sq[jj] = *(const f32x4*)(qs + (size_t)sb * QW + sg * 512 + 256 * jj + 4 * lane); }
#pragma unroll
                for (int r = 0; r < 2; ++r) { const f32x4* rowp = (const f32x4*)(cache + (size_t)(64 * shalf + 16 * (sl & 3) + 2 * w + r) * dil * 1024) + lane;
#pragma unroll
                    for (int c = 0; c < 4; ++c) kv[r][c] = __builtin_nontemporal_load(rowp + 64 * c); } }
            { LAS const unsigned char* kb = lds + k_off(P & 1); LAS const unsigned char* vb = lds + v_off(P & 1);
                const int qtok = task_qtok(d, jq, w, fr); const size_t tq = rowbase + qtok;
                if (d.g < 2) {
                    const int kmin = d.krvalid0 - 16 * w; const int c_lo = kmin >= 32 ? (kmin >> 5) : 0;
                    wave_task(kb, vb, qf, 16 * w, c_lo, 5, 0, 128, kmin, m0, O, lsum, lane);
                    lsum += shfl_xor_f(lsum, 16); lsum += shfl_xor_f(lsum, 32);
#pragma unroll
                    for (int dt = 0; dt < 4; ++dt) Opend[dt] = O[dt];
                    lpend = lsum; ppend = (size_t)d.g * MTOK + tq; pend = true;
                    if (P == 7) ATT_FLUSH();
                } else {
                    const int hi = 32 * jq + 16 * (w & 1) - 64 * d.s;
                    int c_hi = hi + 15 < 0 ? 0 : ((hi + 15) >> 5) + 1; if (c_hi > 2) c_hi = 2;
                    wave_task(kb, vb, qf, 64 * (w >> 1), 0, c_hi, -100000, hi, -100000, m0, O, lsum, lane);
                    if (d.last) {
                        lsum += shfl_xor_f(lsum, 16); lsum += shfl_xor_f(lsum, 32);
                        const float l = lsum + lpart[tq * 8 + h] + lpart[((size_t)MTOK + tq) * 8 + h]; const float inv = 1.0f / l;
                        const bf16_t* op0 = opart + tq * OW + h * 64 + 4 * fq; const bf16_t* op1 = op0 + (size_t)MTOK * OW; bf16_t* od = Ob + tq * OW + h * 64 + 4 * fq;
#pragma unroll
                        for (int dt = 0; dt < 4; ++dt) { const u32x2 a0 = *(const u32x2*)(op0 + 16 * dt), a1 = *(const u32x2*)(op1 + 16 * dt);
                            const f32x4 p0 = {__builtin_bit_cast(float, a0.x << 16), __builtin_bit_cast(float, a0.x & 0xffff0000u), __builtin_bit_cast(float, a0.y << 16), __builtin_bit_cast(float, a0.y & 0xffff0000u)};
                            const f32x4 p1 = {__builtin_bit_cast(float, a1.x << 16), __builtin_bit_cast(float, a1.x & 0xffff0000u), __builtin_bit_cast(float, a1.y << 16), __builtin_bit_cast(float, a1.y & 0xffff0000u)};
                            const f32x4 o = (O[dt] + p0 + p1) * inv;
                            u32x2 pw; pw.x = cvt_pk_bf16(o[0], o[1]); pw.y = cvt_pk_bf16(o[2], o[3]); *(u32x2*)(od + 16 * dt) = pw; }
                    }
                }
            }
            if (has_sl) {
#pragma unroll
                for (int r = 0; r < 2; ++r)
#pragma unroll
                    for (int jj = 0; jj < 2; ++jj) { const f32x4 k = kv[r][jj]; float s = (k[0] * sq[jj][0] + k[1] * sq[jj][1]) + (k[2] * sq[jj][2] + k[3] * sq[jj][3]);
                        s = rowred<16>(s); const float p = __builtin_amdgcn_exp2f(s - m0); sl_[jj] += p; so[jj] += kv[r][2 + jj] * p; }
                if ((sl & 3) == 3) {
                    if (w == 0 && shalf == 1) {
#pragma unroll
                        for (int jj = 0; jj < 2; ++jj) { const f32x4 k = *(const f32x4*)(kn + (size_t)sb * QW + sg * 512 + 256 * jj + 4 * lane), v = *(const f32x4*)(vn + (size_t)sb * QW + sg * 512 + 256 * jj + 4 * lane);
                            float s = (k[0] * sq[jj][0] + k[1] * sq[jj][1]) + (k[2] * sq[jj][2] + k[3] * sq[jj][3]); s = rowred<16>(s); const float p = __builtin_amdgcn_exp2f(s - m0); sl_[jj] += p; so[jj] += v * p; } }
#pragma unroll
                    for (int jj = 0; jj < 2; ++jj) { *(LAS f32x4*)(sred + w * 576 + 256 * jj + 4 * lane) = so[jj]; if ((lane & 15) == 0) sred[w * 576 + 512 + 4 * jj + (lane >> 4)] = sl_[jj];
                        so[jj] = (f32x4){0.f, 0.f, 0.f, 0.f}; sl_[jj] = 0.f; }
                }
            }
            __syncthreads();
            if (has_sl && (sl & 3) == 3) {
                for (int e = F.tid; e < 520; e += 512) { float s = 0.f;
#pragma unroll
                    for (int w8 = 0; w8 < 8; ++w8) s += sred[w8 * 576 + e];
                    if (e < 512) sop[((size_t)(2 * sg + shalf) * NSMP + sb) * OW + e] = s; else slp[((size_t)(2 * sg + shalf) * NSMP + sb) * 8 + (e - 512)] = s; }
            }
        }
    }
    __syncthreads();
}
}

#ifndef RIDE_QKV
#define RIDE_QKV 1
#endif
struct Args { const float* in[N_IN]; float* out; unsigned char* ws; };
__global__ void __launch_bounds__(NWAVES * 64, 2) yoco_fwd(Args args) {
    extern __shared__ __attribute__((aligned(16))) unsigned char lds_raw[];
    Frame F;
    F.lds = (LAS unsigned char*)lds_raw;
    F.MISC = (volatile LAS unsigned*)(F.lds + MISC_OFF);
    F.tid = threadIdx.x; F.lane = F.tid & 63; F.wave = __builtin_amdgcn_readfirstlane(F.tid >> 6);
    F.G = gridDim.x; F.bx = blockIdx.x; F.vcu = (F.G % 8 == 0) ? (F.bx % 8) * (F.G / 8) + F.bx / 8 : F.bx;
    for (int u = F.tid; u < (LDS_BYTES - LDSCTL_OFF) / 4; u += NWAVES * 64) ((LAS unsigned*)(F.lds + LDSCTL_OFF))[u] = 0u;
    __syncthreads();
    if (F.tid == 0) { volatile LAS unsigned long long* tab = (volatile LAS unsigned long long*)(F.lds + PTAB_OFF);
#pragma unroll
        for (int i = 0; i < N_IN; ++i) tab[i] = (unsigned long long)args.in[i];
        tab[N_IN] = (unsigned long long)args.out; tab[N_IN + 1] = (unsigned long long)args.ws; }
    __syncthreads();
    F.out = ptab_out(F); F.ws = ptab_ws(F); F.ctl = (gu32*)(F.ws + WS_CTL); F.ctlf = (float*)(F.ws + WS_CTL);
    const int wave0 = F.wave;
    XcdBarrier bar = xcd_barrier_post((unsigned*)(F.ctl + CW_BAR), F.MISC + 8);
#define GRID_BAR() do { XcdBarrier b_ = bar; long z_ = 0; asm volatile("" : "+s"(z_), "+s"(b_.x)); b_.bar = bar.bar + z_; xcd_barrier(b_); } while (0)

#define PHASE_BEGIN() do { int w_ = wave0; asm volatile("" : "+s"(w_)); int t_; asm volatile("v_mbcnt_lo_u32_b32 %0, -1, 0\n\tv_mbcnt_hi_u32_b32 %0, -1, %0" : "=v"(t_)); t_ += w_ * 64; F.tid = t_; F.lane = t_ & 63; F.wave = __builtin_amdgcn_readfirstlane(t_ >> 6); \
        { int g_ = gridDim.x, b_ = blockIdx.x; asm volatile("" : "+s"(g_), "+s"(b_)); F.G = g_; F.bx = b_; F.vcu = (g_ % 8 == 0) ? (b_ % 8) * (g_ / 8) + b_ / 8 : b_; } \
        F.out = ptab_out(F); F.ws = ptab_ws(F); F.ctl = (gu32*)(F.ws + WS_CTL); F.ctlf = (float*)(F.ws + WS_CTL); } while (0)
#define WSP (F.ws)
#define YP (F.out + O_YP)
#define XBP ((bf16_t*)(F.ws + WS_XB) + XB_PAD_ROWS * DM)
#define XSP ((float*)(F.ws + WS_SMP + SM_XS))
#define YSP (F.out + O_YS)

    PHASE_BEGIN();
    p0_weights(F);
    __syncthreads();
    pool_d_phase<true, false>(F, inp(F, IN_XP), nullptr, inp(F, IN_GPOOL), (bf16_t*)(WSP + WS_DBUF), F.out + O_POOLP);
    smp_pool_d(F, 0, inp(F, IN_XS), true, nullptr);
    GRID_BAR();

    for (int layer = 0; layer < 4; ++layer) {
        pg8::Gemm gm; const float* mix_xin; const float* smp_xin;
        if (layer < 2) {
            if (layer == 1) {
                PHASE_BEGIN();
                pool_d_phase<false, true>(F, XBP, ssp(F, 1), inp(F, IN_GPOOL) + DM, (bf16_t*)(WSP + WS_DBUF), F.out + O_POOLP + (size_t)NBATCH * PHIST * DM);
                smp_pool_d(F, 1, XSP, false, sss(F, 1));
                GRID_BAR();
            }
            gm = pg8::Gemm{(const bf16_t*)(WSP + WS_DBUF), (const bf16_t*)(WSP + WS_WP) + (size_t)layer * 4 * 65536, 256, DM, (long)256 * DM * 2, (long)128 * DM * 2, (long)256 * 2};
            mix_xin = layer == 0 ? inp(F, IN_XP) : nullptr; smp_xin = layer == 0 ? inp(F, IN_XS) : XSP;
        } else {
            const int j = layer - 2;
            {
                PHASE_BEGIN();
                const int nN = layer == 2 ? 18 : 6;
                const pg8::Gemm g{XBP, layer == 2 ? (const bf16_t*)(WSP + WS_WKVQ) : (const bf16_t*)(WSP + WS_WQ3), DM, DM, (long)256 * DM * 2, (long)128 * DM * 2, 0};
                { LAS float* rd = (LAS float*)(F.lds + LDSCTL_OFF + 512); if (F.tid < 128) { const int e = F.tid >> 4; rd[F.tid] = ((const float*)(WSP + WS_ROT))[(128 * (e >> 2) + 16 * (e & 3)) * 16 + (F.tid & 15)]; } __syncthreads(); }
                pg8::StaticOrder S; S.init(MTOK / 256 + RIDE_QKV, nN, F.G, F.bx, RIDE_QKV);
                const pg8::EpiQKV E{ssp(F, 2 * layer - 1), (const float*)(WSP + WS_ROT), WSP, F.out, inp(F, IN_KGAIN), (long)((const char*)(inp(F, IN_QGAIN) + j * HD) - (const char*)inp(F, IN_KGAIN)), 0.125f * LOG2E, layer == 2 ? 12 : 0, (const LAS float*)(F.lds + LDSCTL_OFF + 512)};
                pg8::gemm_phase<pg8::EpiQKV, pg8::StaticOrder, 0>(F.lds + RING_OFF, g, S, E, F.tid);
            }
#if !RIDE_QKV
                PHASE_BEGIN();
                smp_qkv(F, layer, sss(F, 2 * layer - 1));
#endif
                { PHASE_BEGIN(); const int nN2 = layer == 2 ? 18 : 6;
                    convert_weights(F, layer == 2 ? WSEG2B : WSEG3B, layer == 2 ? WSEG3B : WSEG4, ((MTOK / 256 + RIDE_QKV) * nN2) % F.G); }
            GRID_BAR();
            PHASE_BEGIN();
            att::phase(F, j);
            GRID_BAR();
            gm = pg8::Gemm{(const bf16_t*)(WSP + WS_OB), (const bf16_t*)(WSP + WS_WO) + (size_t)j * DM * OW, OW, OW, (long)256 * OW * 2, (long)128 * OW * 2, 0};
            mix_xin = nullptr; smp_xin = XSP;
        }
        {
            if (layer >= 2) { PHASE_BEGIN(); smp_attn_finalize(F, layer); }
            PHASE_BEGIN();
            pg8::StaticOrder S; S.init(MTOK / 256, 4, F.G, F.bx);
            const pg8::EpiResid E{mix_xin, nullptr, XBP, ssp(F, 2 * layer)};
            pg8::gemm_phase<pg8::EpiResid, pg8::StaticOrder, 0>(F.lds + RING_OFF, gm, S, E, F.tid);
            PHASE_BEGIN();
            smp_mixer_gemm(F, layer, smp_xin, XSP, sss(F, 2 * layer));
        }
        GRID_BAR();
        {
            PHASE_BEGIN();
            const pg8::Gemm g{XBP - 2 * DM, (const bf16_t*)(WSP + WS_WUP) + (size_t)layer * DUP * DM, DM, DM, (long)252 * DM * 2, (long)4 * DM * 2, 0};
            pg8::UpOrder S; S.init(F.G, F.bx);
            const pg8::EpiUp E{(bf16_t*)(WSP + WS_ACT), ssp(F, 2 * layer), inp(F, IN_CONVW) + (size_t)layer * 3 * DUP, inp(F, IN_CONVB) + (size_t)layer * DUP, F.out + O_CONVP + (size_t)layer * NBATCH * 2 * DUP, (LAS float*)(F.lds + LDSCTL_OFF + 1024), layer};
            pg8::gemm_phase<pg8::EpiUp, pg8::UpOrder, 1>(F.lds + RING_OFF, g, S, E, F.tid);
            if (layer == 0) {
                const int lo = (66 * 22) % F.G, rd = lo + 22 <= F.G ? 22 : 0;
                PHASE_BEGIN(); convert_weights(F, WSEG1, WSEG1 + F.G, 0);
                PHASE_BEGIN(); convert_weights(F, WSEG1 + F.G, WSEG1 + F.G + 2 * rd, lo, lo + rd);
                PHASE_BEGIN(); convert_weights(F, WSEG1 + F.G + 2 * rd, WSEG2, lo + rd < F.G ? lo + rd : 0); }
            if (layer == 1) { const int lo = (66 * 22) % F.G, rd = lo + 22 <= F.G ? 22 : 0; PHASE_BEGIN(); convert_weights(F, WSEG2, WSEG2B, lo + rd < F.G ? lo + rd : 0); }
        }
        GRID_BAR();
        {
            PHASE_BEGIN();
            const pg8::Gemm g{(const bf16_t*)(WSP + WS_ACT), (const bf16_t*)(WSP + WS_WDOWN) + (size_t)layer * DM * DFF, DFF, DFF, (long)256 * DFF * 2, (long)128 * DFF * 2, 0};
            pg8::StaticOrder S; S.init(MTOK / 256, 4, F.G, F.bx);
            const pg8::EpiResid E{nullptr, layer == 3 ? YP : nullptr, XBP, layer < 3 ? ssp(F, 2 * layer + 1) : nullptr};
            pg8::gemm_phase<pg8::EpiResid, pg8::StaticOrder, 0>(F.lds + RING_OFF, g, S, E, F.tid);
            PHASE_BEGIN();
            smp_down(F, layer, XSP, layer < 3 ? XSP : YSP, layer < 3 ? sss(F, 2 * layer + 1) : nullptr);
        }
        if (layer < 3) GRID_BAR();
    }
    if (blockIdx.x == 0 && F.tid == 0 && __hip_atomic_load((unsigned*)(F.ctl + CW_BAR) + XB_TMO, RLX_AGENT) != 0u) F.out[O_YS] = __builtin_nanf("");
#undef GRID_BAR
#undef PHASE_BEGIN
#undef WSP
#undef YP
#undef XBP
#undef XSP
#undef YSP
}

extern "C" void kernel_launch(void* const* d_in, const int* in_sizes, int n_in, void* d_out, int out_size, void* d_ws, size_t ws_size, hipStream_t stream) {
    static int grid = 0;
    if (grid == 0) {
        if (n_in != N_IN || in_sizes[0] != MTOK * DM || (size_t)out_size != O_END || ws_size < WS_END) { fprintf(stderr, "kernel_launch: unexpected shapes (n_in %d, in0 %d, out %d, ws %zu); nothing launched\n", n_in, n_in > 0 ? in_sizes[0] : -1, out_size, ws_size); grid = -1; return; }
        int dev = 0, cus = 0, per_cu = 0;
        if (hipGetDevice(&dev) != hipSuccess || hipDeviceGetAttribute(&cus, hipDeviceAttributeMultiprocessorCount, dev) != hipSuccess) { grid = -1; return; }
        if (hipFuncSetAttribute((const void*)yoco_fwd, hipFuncAttributeMaxDynamicSharedMemorySize, LDS_BYTES) != hipSuccess) { fprintf(stderr, "kernel_launch: hipFuncSetAttribute failed\n"); grid = -1; return; }
        if (hipOccupancyMaxActiveBlocksPerMultiprocessor(&per_cu, (const void*)yoco_fwd, NWAVES * 64, LDS_BYTES) != hipSuccess || per_cu < 1)
            fprintf(stderr, "kernel_launch: note: occupancy query reports %d workgroups per CU\n", per_cu);
        (void)hipGetLastError();
        grid = cus;
    }
    if (grid < 0) return;
    if (hipMemsetAsync((char*)d_ws + WS_CTL, 0, CTL_ZERO_BYTES, stream) != hipSuccess) { fprintf(stderr, "kernel_launch: hipMemsetAsync failed\n"); return; }
    Args a{};
    for (int i = 0; i < N_IN; ++i) a.in[i] = (const float*)d_in[i];
    a.out = (float*)d_out; a.ws = (unsigned char*)d_ws;
    hipLaunchKernelGGL(yoco_fwd, dim3(grid), dim3(NWAVES * 64), LDS_BYTES, stream, a);
    const hipError_t le = hipPeekAtLastError();
    if (le != hipSuccess) fprintf(stderr, "kernel_launch: launch failed: %s (grid %d)\n", hipGetErrorName(le), grid);
}
```
